# Optimizing an MI355X kernel written in HIP

```python
import jax, jax.numpy as jnp
from jax import lax
import numpy as np

D_MODEL = 4096
BATCH = 4
SEQ = 2048
DEPTH = 1

CHUNK = 64
Q_BLOCK = 128
N_MEM = 256
MIX_WIDTH = D_MODEL
FOX_WIDTH = MIX_WIDTH // 2
FOX_HEAD_DIM = 128
FOX_HEADS = FOX_WIDTH // FOX_HEAD_DIM
RWKV_WIDTH = MIX_WIDTH - FOX_WIDTH
RWKV_HEAD_DIM = 64
RWKV_HEADS = RWKV_WIDTH // RWKV_HEAD_DIM
DECAY_LORA = 96
ICLR_LORA = 96
GATE_LORA = 256
FOX_COLS = 3 * FOX_WIDTH + FOX_HEADS
RWKV_SHIFT_COLS = 3 * RWKV_WIDTH + DECAY_LORA + ICLR_LORA + GATE_LORA
IN_COLS = FOX_COLS + RWKV_SHIFT_COLS
XATTN_HEADS = 4
XATTN_HEAD_DIM = D_MODEL // XATTN_HEADS
D_FF = 11008
RMS_EPS = 1e-6
RWKV_GN_EPS = 64e-5
NEG_INF = -1e30

kernel_name = 'fox_rwkv7_macaron_sandwich_memory_layer'


def rms_norm(x, g):
    xf = x.astype(jnp.float32)
    y = xf * lax.rsqrt(jnp.mean(xf * xf, axis=-1, keepdims=True) + RMS_EPS)
    return (y * g.astype(jnp.float32)).astype(x.dtype)


def swiglu(h, w_gate, w_up, w_down):
    u = jax.nn.silu(jnp.einsum('bsd,df->bsf', h, w_gate)) * jnp.einsum('bsd,df->bsf', h, w_up)
    return jnp.einsum('bsf,fd->bsd', u, w_down)


def fox_attention(q, k, v, logf):
    seq = q.shape[1]
    c = jnp.cumsum(logf, axis=1).transpose(0, 2, 1)
    scale = FOX_HEAD_DIM ** -0.5
    outs = []
    for blk in range(seq // Q_BLOCK):
        q0, q1 = blk * Q_BLOCK, (blk + 1) * Q_BLOCK
        s = jnp.einsum('bqhd,bkhd->bhqk', q[:, q0:q1], k[:, :q1]).astype(jnp.float32) * scale
        s = s + c[:, :, q0:q1, None] - c[:, :, None, :q1]
        causal = (q0 + jnp.arange(Q_BLOCK))[:, None] >= jnp.arange(q1)[None, :]
        p = jax.nn.softmax(jnp.where(causal, s, NEG_INF), axis=-1)
        outs.append(jnp.einsum('bhqk,bkhd->bqhd', p.astype(v.dtype), v[:, :q1]))
    return jnp.concatenate(outs, axis=1)


def rwkv7_recurrence(r, decay, k, v, kk, a):
    b, _, h, n = r.shape

    def step(state, inp):
        r_t, w_t, k_t, v_t, kk_t, a_t = inp
        s_kk = jnp.einsum('bhvk,bhk->bhv', state, kk_t)
        state = (state * w_t[:, :, None, :]
                 - s_kk[..., None] * (kk_t * a_t)[:, :, None, :]
                 + v_t[..., None] * k_t[:, :, None, :])
        return state, jnp.einsum('bhvk,bhk->bhv', state, r_t)

    xs = tuple(jnp.swapaxes(t.astype(jnp.float32), 0, 1) for t in (r, decay, k, v, kk, a))
    state0 = jnp.zeros((b, h, n, n), jnp.float32)
    _, y = lax.scan(step, state0, xs)
    return jnp.swapaxes(y, 0, 1)


def parallel_mixer(h, w_in, fox_f_bias, rwkv_mu, rwkv_w0, rwkv_w_up, rwkv_a0, rwkv_a_up,
                   rwkv_g_up, rwkv_k_k, rwkv_k_a, rwkv_r_k, rwkv_ln_w, rwkv_ln_b, w_out):
    b, s, _ = h.shape
    proj = jnp.einsum('bsd,dc->bsc', h, w_in)
    fox_proj, rwkv_proj = proj[..., :FOX_COLS], proj[..., FOX_COLS:]

    q, k, v, f_logit = jnp.split(fox_proj, [FOX_WIDTH, 2 * FOX_WIDTH, 3 * FOX_WIDTH], axis=-1)
    fox_heads = lambda t: t.reshape(b, s, FOX_HEADS, FOX_HEAD_DIM)
    logf = jax.nn.log_sigmoid((f_logit + fox_f_bias).astype(jnp.float32))
    y_fox = fox_attention(fox_heads(q), fox_heads(k), fox_heads(v), logf).reshape(b, s, FOX_WIDTH)

    prev = jnp.pad(rwkv_proj, ((0, 0), (1, 0), (0, 0)))[:, :-1]
    z = rwkv_proj + rwkv_mu * (prev - rwkv_proj)
    r, kr, vr, xw, xa, xg = jnp.split(
        z, [RWKV_WIDTH, 2 * RWKV_WIDTH, 3 * RWKV_WIDTH, 3 * RWKV_WIDTH + DECAY_LORA,
            3 * RWKV_WIDTH + DECAY_LORA + ICLR_LORA], axis=-1)
    w_log = -jax.nn.softplus(-(rwkv_w0 + jnp.tanh(xw) @ rwkv_w_up).astype(jnp.float32)) - 0.5
    decay = jnp.exp(-jnp.exp(w_log))
    a = jax.nn.sigmoid((rwkv_a0 + xa @ rwkv_a_up).astype(jnp.float32))
    g = (jax.nn.sigmoid(xg) @ rwkv_g_up).astype(jnp.float32)
    hn = lambda t: t.astype(jnp.float32).reshape(b, s, RWKV_HEADS, RWKV_HEAD_DIM)
    pn = lambda p: p.astype(jnp.float32).reshape(RWKV_HEADS, RWKV_HEAD_DIM)
    rf, kf, vf, decay, a = hn(r), hn(kr), hn(vr), hn(decay), hn(a)
    kk = kf * pn(rwkv_k_k)
    kk = kk / jnp.maximum(jnp.sqrt(jnp.sum(kk * kk, axis=-1, keepdims=True)), 1e-12)
    kf = kf * (1.0 + (a - 1.0) * pn(rwkv_k_a))
    y = rwkv7_recurrence(rf, decay, kf, vf, kk, a)
    mean = jnp.mean(y, axis=-1, keepdims=True)
    var = jnp.mean(jnp.square(y - mean), axis=-1, keepdims=True)
    yn = ((y - mean) * lax.rsqrt(var + RWKV_GN_EPS)).reshape(b, s, RWKV_WIDTH)
    yn = yn * rwkv_ln_w.astype(jnp.float32) + rwkv_ln_b.astype(jnp.float32)
    bonus = (jnp.sum(rf * kf * pn(rwkv_r_k), axis=-1, keepdims=True) * vf).reshape(b, s, RWKV_WIDTH)
    y_rwkv = ((yn + bonus) * g).astype(h.dtype)

    return jnp.einsum('bsc,cd->bsd', jnp.concatenate([y_fox, y_rwkv], axis=-1), w_out)


def cross_attention(h, m, wq, wk, wv, wo):
    b, s, _ = h.shape
    q = jnp.einsum('bsd,dc->bsc', h, wq).reshape(b, s, XATTN_HEADS, XATTN_HEAD_DIM)
    k = jnp.einsum('bmd,dc->bmc', m, wk).reshape(b, m.shape[1], XATTN_HEADS, XATTN_HEAD_DIM)
    v = jnp.einsum('bmd,dc->bmc', m, wv).reshape(b, m.shape[1], XATTN_HEADS, XATTN_HEAD_DIM)
    sc = jnp.einsum('bqhd,bkhd->bhqk', q, k).astype(jnp.float32) * (XATTN_HEAD_DIM ** -0.5)
    p = jax.nn.softmax(sc, axis=-1).astype(v.dtype)
    o = jnp.einsum('bhqk,bkhd->bqhd', p, v).reshape(b, s, D_MODEL)
    return jnp.einsum('bsc,cd->bsd', o, wo)


def setup_inputs(seed: int = 0) -> dict:
    key = jax.random.key(seed)
    ks = iter(jax.random.split(key, 48))
    nrm = lambda shape, scale: scale * jax.random.normal(next(ks), shape, jnp.float32)
    uni = lambda shape, lo, hi: jax.random.uniform(next(ks), shape, jnp.float32, lo, hi)
    gain = lambda width: 1.0 + nrm((DEPTH, width), 0.05)
    L, D = DEPTH, D_MODEL
    return {
        'x': nrm((BATCH, SEQ, D), 1.0),
        'mem': nrm((BATCH, N_MEM, D), 1.0),
        'ffn1_pre_g': gain(D),
        'ffn1_w_gate': nrm((L, D, D_FF), D ** -0.5),
        'ffn1_w_up': nrm((L, D, D_FF), D ** -0.5),
        'ffn1_w_down': nrm((L, D_FF, D), D_FF ** -0.5),
        'ffn1_post_g': gain(D),
        'mix_pre_g': gain(D),
        'w_in': nrm((L, D, IN_COLS), D ** -0.5),
        'fox_f_bias': uni((L, FOX_HEADS), 1.0, 5.0),
        'rwkv_mu': uni((L, RWKV_SHIFT_COLS), 0.0, 1.0),
        'rwkv_w0': uni((L, RWKV_WIDTH), -6.0, -1.0),
        'rwkv_w_up': nrm((L, DECAY_LORA, RWKV_WIDTH), 0.1),
        'rwkv_a0': nrm((L, RWKV_WIDTH), 0.1),
        'rwkv_a_up': nrm((L, ICLR_LORA, RWKV_WIDTH), ICLR_LORA ** -0.5),
        'rwkv_g_up': nrm((L, GATE_LORA, RWKV_WIDTH), GATE_LORA ** -0.5),
        'rwkv_k_k': 0.85 + nrm((L, RWKV_WIDTH), 0.02),
        'rwkv_k_a': 1.0 + nrm((L, RWKV_WIDTH), 0.02),
        'rwkv_r_k': nrm((L, RWKV_WIDTH), 0.1),
        'rwkv_ln_w': gain(RWKV_WIDTH),
        'rwkv_ln_b': nrm((L, RWKV_WIDTH), 0.01),
        'w_out': nrm((L, MIX_WIDTH, D), MIX_WIDTH ** -0.5),
        'mix_post_g': gain(D),
        'xattn_pre_g': gain(D),
        'mem_norm_g': gain(D),
        'xattn_wq': nrm((L, D, D), D ** -0.5),
        'xattn_wk': nrm((L, D, D), D ** -0.5),
        'xattn_wv': nrm((L, D, D), D ** -0.5),
        'xattn_wo': nrm((L, D, D), D ** -0.5),
        'xattn_post_g': gain(D),
        'ffn2_pre_g': gain(D),
        'ffn2_w_gate': nrm((L, D, D_FF), D ** -0.5),
        'ffn2_w_up': nrm((L, D, D_FF), D ** -0.5),
        'ffn2_w_down': nrm((L, D_FF, D), D_FF ** -0.5),
        'ffn2_post_g': gain(D),
    }


def reference(x, mem, ffn1_pre_g, ffn1_w_gate, ffn1_w_up, ffn1_w_down, ffn1_post_g,
              mix_pre_g, w_in, fox_f_bias, rwkv_mu, rwkv_w0, rwkv_w_up, rwkv_a0, rwkv_a_up,
              rwkv_g_up, rwkv_k_k, rwkv_k_a, rwkv_r_k, rwkv_ln_w, rwkv_ln_b, w_out, mix_post_g,
              xattn_pre_g, mem_norm_g, xattn_wq, xattn_wk, xattn_wv, xattn_wo, xattn_post_g,
              ffn2_pre_g, ffn2_w_gate, ffn2_w_up, ffn2_w_down, ffn2_post_g):
    for l in range(DEPTH):
        x = x + 0.5 * rms_norm(swiglu(rms_norm(x, ffn1_pre_g[l]), ffn1_w_gate[l], ffn1_w_up[l],
                                      ffn1_w_down[l]), ffn1_post_g[l])
        mixed = parallel_mixer(rms_norm(x, mix_pre_g[l]), w_in[l], fox_f_bias[l], rwkv_mu[l],
                               rwkv_w0[l], rwkv_w_up[l], rwkv_a0[l], rwkv_a_up[l], rwkv_g_up[l],
                               rwkv_k_k[l], rwkv_k_a[l], rwkv_r_k[l], rwkv_ln_w[l], rwkv_ln_b[l],
                               w_out[l])
        x = x + rms_norm(mixed, mix_post_g[l])
        xa = cross_attention(rms_norm(x, xattn_pre_g[l]), rms_norm(mem, mem_norm_g[l]),
                             xattn_wq[l], xattn_wk[l], xattn_wv[l], xattn_wo[l])
        x = x + rms_norm(xa, xattn_post_g[l])
        x = x + 0.5 * rms_norm(swiglu(rms_norm(x, ffn2_pre_g[l]), ffn2_w_gate[l], ffn2_w_up[l],
                                      ffn2_w_down[l]), ffn2_post_g[l])
    return x
```

```cpp
#include <hip/hip_runtime.h>
#include <cstdio>
#include <cstdint>

#ifndef FOX_PRIO
#define FOX_PRIO 0
#endif
#define MK_PH_BEG 0
#define MK_PH_END 19
#define P0_PARTS 7
#define CVT_LO 0
#define CVT_HI CVT_EARLY
#define GAS __attribute__((address_space(1)))
#define LAS __attribute__((address_space(3)))
#define DI __device__ __forceinline__
typedef unsigned short bf16;
typedef short bf16x8 __attribute__((ext_vector_type(8)));
typedef short s16x4 __attribute__((ext_vector_type(4)));
typedef float f32x2 __attribute__((ext_vector_type(2)));
typedef float f32x4 __attribute__((ext_vector_type(4)));
typedef float f32x16 __attribute__((ext_vector_type(16)));
typedef unsigned u32x2 __attribute__((ext_vector_type(2)));
typedef unsigned u32x4 __attribute__((ext_vector_type(4)));
typedef __bf16 bf16x2_t __attribute__((ext_vector_type(2)));

DI int lane_id() { int l; asm volatile("v_mbcnt_lo_u32_b32 %0, -1, 0\n\tv_mbcnt_hi_u32_b32 %0, -1, %0" : "=v"(l)); return l; }
DI unsigned pk2(float lo, float hi) { f32x2 f = {lo, hi}; return __builtin_bit_cast(unsigned, __builtin_convertvector(f, bf16x2_t)); }
DI float bflo(unsigned u) { return __uint_as_float(u << 16); }
DI float bfhi(unsigned u) { return __uint_as_float(u & 0xffff0000u); }
DI float bf2f(bf16 b) { return __uint_as_float((unsigned)b << 16); }

constexpr int BATCH = 4, SEQ = 2048, M = BATCH * SEQ, D = 4096, FF = 11008, NGU = 2 * FF;
constexpr int NMEM = 256, MM = BATCH * NMEM;
constexpr int FOXH = 16, FOXD = 128, RH = 32, RD = 64, RW = 2048;
constexpr int IN_COLS = 12752, NIN = 12800;
constexpr int PC_RKV = 6144, PC_LORA = 12288, PC_FL = 12736;
constexpr int LORA_K = 256, ALD = 3 * LORA_K;
constexpr float RMS_EPS = 1e-6f, GN_EPS = 64e-5f, LOG2E = 1.4426950408889634f;

constexpr size_t MiB = 1u << 20;
constexpr size_t WS_CTL = 0, CTL_ZERO_BYTES = 1 * MiB;
constexpr size_t WS_P1CTR = WS_CTL + 900 * 1024;
constexpr size_t WS_RSTD = WS_CTL + 512 * 1024;
constexpr size_t WS_C = 1 * MiB;
constexpr size_t WS_FL = WS_C + 512 * 1024;
constexpr size_t WS_BON = 2 * MiB;
constexpr size_t WS_LORAW = 3 * MiB;
constexpr size_t WS_MEMN = 8 * MiB;
constexpr size_t WS_KMEM = 16 * MiB;
constexpr size_t WS_VT = 24 * MiB;
constexpr size_t WS_W_IN = 32 * MiB;
constexpr size_t WS_W_OUT = 132 * MiB, WS_WQ = 164 * MiB, WS_WO = 196 * MiB, WS_WK = 228 * MiB, WS_WV = 260 * MiB;
constexpr size_t WS_F1GU = 292 * MiB, WS_F1D = 464 * MiB, WS_F2GU = 550 * MiB, WS_F2D = 722 * MiB;
constexpr size_t WS_X = 808 * MiB;
constexpr size_t WS_Y = 936 * MiB;
constexpr size_t WS_WDEC = WS_Y, WS_AA = WS_Y + 64 * MiB;
constexpr size_t WS_H = 1064 * MiB;
constexpr size_t WS_YR = WS_H;
constexpr size_t WS_ACT2 = 1128 * MiB;
constexpr size_t WS_BIG = 1192 * MiB;
constexpr size_t WS_RR = 1392 * MiB, WS_RKM = 1424 * MiB, WS_RV = 1456 * MiB, WS_RKK = 1488 * MiB, WS_RKKA = 1520 * MiB;
constexpr size_t WS_G = 1552 * MiB;
constexpr size_t WS_ALORA = 1584 * MiB;
constexpr size_t WS_END = 1596 * MiB;

namespace pg8 {
typedef unsigned short bf16_t;
constexpr int BM = 256, BK = 64, HALF = 128, HTB = HALF * BK * 2, STAGE_BYTES = 8 * HTB, NXCD = 8, WGM = 8;
__host__ __device__ __forceinline__ int lds_byte(int r, int c) { const int st = (r >> 4) * 2 + (c >> 5), rr = r & 15, cc = c & 31, ob = rr * 64 + cc * 2; return st * 1024 + (ob ^ (((ob >> 9) & 1) << 5)); }
__host__ __device__ __forceinline__ void stage_rc(int b, int& R, int& C) { const int st = b / 1024, sb = b % 1024, swz = sb ^ (((sb >> 9) & 1) << 5); R = (st >> 1) * 16 + swz / 64; C = (st & 1) * 32 + (swz % 64) / 2; }
__host__ __device__ __forceinline__ int perm32(int rho) { const int n = rho >> 4, i = rho & 15; return 8 * (i >> 2) + 4 * n + (i & 3); }

struct Unit { int pm, pn, z; };
struct BatchOff { long hi, lo; int div; DI long off(int z) const { return (long)(z / div) * hi + (long)(z % div) * lo; } };
struct Gemm { const bf16_t* A; const bf16_t* Bt; int lda, ldb, K; BatchOff za, zb; };

struct StaticOrder {
    int nM, nN, nwg, nall, G, c;
    DI void init(int Mr, int Nc, int nz, int G_, int c_) { nM = Mr / BM; nN = Nc / BM; nwg = nM * nN; nall = nwg * nz; G = G_; c = c_; }
    DI bool next(int i, Unit& u) const {
        const long L = (long)i * G + c; if (L >= nall) return false;
        const int z = (int)(L / nwg); int wgid = (int)(L - (long)z * nwg);
        { const int q = nwg / NXCD, r = nwg % NXCD, xcd = wgid % NXCD, off = wgid / NXCD; wgid = (xcd < r ? xcd * (q + 1) : r * (q + 1) + (xcd - r) * q) + off; }
        const int nig = WGM * nN, gid = wgid / nig, fm = gid * WGM, gsz = (nM - fm) < WGM ? (nM - fm) : WGM;
        u.pm = fm + ((wgid % nig) % gsz); u.pn = (wgid % nig) / gsz; u.z = z; return true;
    }
};

typedef int i32x4 __attribute__((ext_vector_type(4)));
typedef int i32x8 __attribute__((ext_vector_type(8)));
template <class Epi, bool ALIGN_EPI = true, bool SP2 = true, bool F8 = false>
DI void gemm_phase(LAS unsigned char* lds, const Gemm g, const StaticOrder& S, const Epi& E, const int wid) {
    const int lane = lane_id(), tid = wid * 64 + lane, wr = wid >> 2, wc = wid & 3, fr = lane & 15, fq = lane >> 4;
    const int K = g.K, nt = K / BK;
    unsigned voff_A, voff_B;
    { int R, C; stage_rc(tid * 16, R, C); const int Rb = Epi::PERM ? ((R & ~31) + perm32(R & 31)) : R; voff_A = (unsigned)(R * g.lda + C) * 2u; voff_B = (unsigned)(Rb * g.ldb + C) * 2u; }
    const size_t r64A = (size_t)64 * g.lda * 2, r64B = (size_t)64 * g.ldb * 2;
    const size_t kstep = (size_t)(BK * 2);
    const size_t hstepA = (size_t)HALF * g.lda * 2, hstepB = (size_t)HALF * g.ldb * 2;
    const size_t tstepA = 2 * hstepA, tstepB = 2 * hstepB;
    const unsigned ldsw = (unsigned)wid * 1024u;
    const int aoff = lds_byte(wr * 64 + fr, fq * 8), boff = lds_byte(wc * 32 + fr, fq * 8);
#define PG8_SA(b, h) (((b) * 2 + (h)) * HTB)
#define PG8_SB(b, h) ((4 + (b) * 2 + (h)) * HTB)
#define PG8_STAGE(bufoff, gbase, voff) do { _Pragma("unroll") for (int _i = 0; _i < 2; ++_i) \
        __builtin_amdgcn_global_load_lds((const unsigned*)((const char*)(gbase) + (size_t)_i * r64##voff + voff_##voff), (LAS unsigned*)(lds + (bufoff) + ldsw + _i * 8192), 16, 0, 0); } while (0)
#define PG8_LDA(dst, b, h) do { _Pragma("unroll") for (int m = 0; m < 4; ++m) { if constexpr (F8) { const i32x4 _l = *(const LAS i32x4*)(lds + PG8_SA(b, h) + aoff + m * 2048), _h = *(const LAS i32x4*)(lds + PG8_SA(b, h) + aoff + m * 2048 + 1024); dst##8[m] = __builtin_shufflevector(_l, _h, 0, 1, 2, 3, 4, 5, 6, 7); } \
        else { _Pragma("unroll") for (int k = 0; k < 2; ++k) dst[m][k] = *(const LAS bf16x8*)(lds + PG8_SA(b, h) + aoff + m * 2048 + k * 1024); } } } while (0)
#define PG8_LDB(dst, b, h) do { _Pragma("unroll") for (int n = 0; n < 2; ++n) { if constexpr (F8) { const i32x4 _l = *(const LAS i32x4*)(lds + PG8_SB(b, h) + boff + n * 2048), _h = *(const LAS i32x4*)(lds + PG8_SB(b, h) + boff + n * 2048 + 1024); dst##8[n] = __builtin_shufflevector(_l, _h, 0, 1, 2, 3, 4, 5, 6, 7); } \
        else { _Pragma("unroll") for (int k = 0; k < 2; ++k) dst[n][k] = *(const LAS bf16x8*)(lds + PG8_SB(b, h) + boff + n * 2048 + k * 1024); } } } while (0)
#define PG8_MMA(ai, bj, At, Bt) do { __builtin_amdgcn_s_setprio(1); _Pragma("unroll") for (int m = 0; m < 4; ++m) _Pragma("unroll") for (int n = 0; n < 2; ++n) { \
        if constexpr (F8) acc[ai][bj][m][n] = __builtin_amdgcn_mfma_scale_f32_16x16x128_f8f6f4(Bt##8[n], At##8[m], acc[ai][bj][m][n], 0, 0, 0, 0, 0, 0);     \
        else { _Pragma("unroll") for (int k = 0; k < 2; ++k) acc[ai][bj][m][n] = __builtin_amdgcn_mfma_f32_16x16x32_bf16(Bt[n][k], At[m][k], acc[ai][bj][m][n], 0, 0, 0); } } \
        __builtin_amdgcn_s_setprio(0); } while (0)
#define PG8_WAIT_V(n) asm volatile("s_waitcnt vmcnt(" #n ")" ::: "memory")
#define PG8_WAIT_L(n) asm volatile("s_waitcnt lgkmcnt(" #n ")" ::: "memory")
#define PG8_BAR __builtin_amdgcn_s_barrier()
#define PG8_SCHED __builtin_amdgcn_sched_barrier(0)
    Unit cur, nxt; int ui = 0;
    if (!S.next(0, cur)) return;
    f32x4 acc[2][2][4][2];
#pragma unroll
    for (int a = 0; a < 2; ++a)
#pragma unroll
        for (int b = 0; b < 2; ++b)
#pragma unroll
            for (int m = 0; m < 4; ++m)
#pragma unroll
                for (int n = 0; n < 2; ++n) acc[a][b][m][n] = (f32x4){0.f, 0.f, 0.f, 0.f};
    bf16x8 At[4][2], B0[2][2], B1[2][2]; i32x8 At8[4], B08[2], B18[2];
    const char* cA = (const char*)(g.A + g.za.off(cur.z)) + (size_t)cur.pm * tstepA; const char* cB = (const char*)(g.Bt + g.zb.off(cur.z)) + (size_t)cur.pn * tstepB;
    if constexpr (SP2) {
        PG8_STAGE(PG8_SB(0, 0), cB, B); PG8_STAGE(PG8_SB(0, 1), cB + hstepB, B); PG8_STAGE(PG8_SA(0, 0), cA, A); PG8_STAGE(PG8_SA(0, 1), cA + hstepA, A);
        if (wr == 1) PG8_BAR;
        PG8_WAIT_V(2); PG8_BAR;
        PG8_STAGE(PG8_SB(1, 0), cB + kstep, B); PG8_STAGE(PG8_SA(1, 0), cA + kstep, A); PG8_STAGE(PG8_SB(1, 1), cB + hstepB + kstep, B);
        PG8_WAIT_V(6); PG8_BAR;
    } else {
        PG8_STAGE(PG8_SB(0, 0), cB, B); PG8_STAGE(PG8_SA(0, 0), cA, A); PG8_STAGE(PG8_SB(0, 1), cB + hstepB, B); PG8_STAGE(PG8_SA(0, 1), cA + hstepA, A);
        if (wr == 1) PG8_BAR;
        PG8_WAIT_V(4); PG8_BAR;
        PG8_STAGE(PG8_SB(1, 0), cB + kstep, B); PG8_STAGE(PG8_SA(1, 0), cA + kstep, A); PG8_STAGE(PG8_SB(1, 1), cB + hstepB + kstep, B);
        PG8_WAIT_V(6); PG8_BAR;
    }
    for (;;) {
        const bool has_next = S.next(ui + 1, nxt);
        const char* nA = has_next ? (const char*)(g.A + g.za.off(nxt.z)) + (size_t)nxt.pm * tstepA : cA; const char* nB = has_next ? (const char*)(g.Bt + g.zb.off(nxt.z)) + (size_t)nxt.pn * tstepB : cB;
        for (int t = 0; t < nt; t += 2) {
            const bool last = (t == nt - 2);
            const char* a1 = cA + (size_t)(t + 1) * kstep;
            const char* a2 = last ? nA : cA + (size_t)(t + 2) * kstep; const char* b2 = last ? nB : cB + (size_t)(t + 2) * kstep;
            const char* a3 = a2 + kstep; const char* b3 = b2 + kstep;
            if constexpr (SP2) {
            PG8_LDB(B0, 0, 0); PG8_LDB(B1, 0, 1); PG8_SCHED; PG8_LDA(At, 0, 0); PG8_STAGE(PG8_SA(1, 1), a1 + hstepA, A);
            PG8_WAIT_V(8); PG8_WAIT_L(0); PG8_BAR; PG8_MMA(0, 0, At, B0); PG8_MMA(0, 1, At, B1); PG8_BAR; PG8_SCHED;
            PG8_LDA(At, 0, 1); PG8_STAGE(PG8_SB(0, 0), b2, B); PG8_STAGE(PG8_SB(0, 1), b2 + hstepB, B); PG8_STAGE(PG8_SA(0, 0), a2, A);
            PG8_WAIT_V(8); PG8_WAIT_L(0); PG8_BAR; PG8_MMA(1, 0, At, B0); PG8_MMA(1, 1, At, B1); PG8_BAR; PG8_SCHED;
            PG8_LDB(B0, 1, 0); PG8_LDB(B1, 1, 1); PG8_SCHED; PG8_LDA(At, 1, 0); PG8_STAGE(PG8_SA(0, 1), a2 + hstepA, A);
            PG8_WAIT_V(8); PG8_WAIT_L(0); PG8_BAR; PG8_MMA(0, 0, At, B0); PG8_MMA(0, 1, At, B1); PG8_BAR; PG8_SCHED;
            PG8_LDA(At, 1, 1); PG8_STAGE(PG8_SB(1, 0), b3, B); PG8_STAGE(PG8_SB(1, 1), b3 + hstepB, B); PG8_STAGE(PG8_SA(1, 0), a3, A);
            PG8_WAIT_V(8); PG8_WAIT_L(0); PG8_BAR; PG8_MMA(1, 0, At, B0); PG8_MMA(1, 1, At, B1); PG8_BAR; PG8_SCHED;
            } else {
            PG8_LDB(B0, 0, 0); PG8_SCHED; PG8_LDA(At, 0, 0); PG8_STAGE(PG8_SA(1, 1), a1 + hstepA, A);
            PG8_WAIT_L(8); PG8_BAR; PG8_WAIT_L(0); PG8_MMA(0, 0, At, B0); PG8_BAR; PG8_SCHED;
            PG8_LDB(B1, 0, 1); PG8_STAGE(PG8_SB(0, 0), b2, B);
            PG8_BAR; PG8_WAIT_L(0); PG8_MMA(0, 1, At, B1); PG8_BAR;
            PG8_LDA(At, 0, 1); PG8_STAGE(PG8_SA(0, 0), a2, A);
            PG8_BAR; PG8_WAIT_L(0); PG8_MMA(1, 0, At, B0); PG8_BAR; PG8_SCHED;
            PG8_STAGE(PG8_SB(0, 1), b2 + hstepB, B);
            PG8_WAIT_V(6); PG8_BAR; PG8_MMA(1, 1, At, B1); PG8_BAR;
            PG8_LDB(B0, 1, 0); PG8_SCHED; PG8_LDA(At, 1, 0); PG8_STAGE(PG8_SA(0, 1), a2 + hstepA, A);
            PG8_WAIT_L(8); PG8_BAR; PG8_WAIT_L(0); PG8_MMA(0, 0, At, B0); PG8_BAR; PG8_SCHED;
            PG8_LDB(B1, 1, 1); PG8_STAGE(PG8_SB(1, 0), b3, B);
            PG8_BAR; PG8_WAIT_L(0); PG8_MMA(0, 1, At, B1); PG8_BAR;
            PG8_LDA(At, 1, 1); PG8_STAGE(PG8_SA(1, 0), a3, A);
            PG8_BAR; PG8_WAIT_L(0); PG8_MMA(1, 0, At, B0); PG8_BAR; PG8_SCHED;
            PG8_STAGE(PG8_SB(1, 1), b3 + hstepB, B);
            PG8_WAIT_V(6); PG8_BAR; PG8_MMA(1, 1, At, B1); PG8_BAR;
            }
        }
        if constexpr (ALIGN_EPI) { if (wr == 0) PG8_BAR; }
        if constexpr (!Epi::AFTER_DRAIN) {
            const int lz = lane_id(); E(acc, cur, wr, wc, lz & 15, lz >> 4); }
        if (!has_next) break;
#pragma unroll
        for (int a = 0; a < 2; ++a)
#pragma unroll
            for (int b = 0; b < 2; ++b)
#pragma unroll
                for (int m = 0; m < 4; ++m)
#pragma unroll
                    for (int n = 0; n < 2; ++n) acc[a][b][m][n] = (f32x4){0.f, 0.f, 0.f, 0.f};
        cur = nxt; cA = nA; cB = nB; ++ui;
        if constexpr (ALIGN_EPI) { if (wr == 1) PG8_BAR; }
    }
    PG8_WAIT_V(0);
    if constexpr (!ALIGN_EPI) { if (wr == 0) PG8_BAR; }
    PG8_BAR;
    if constexpr (Epi::AFTER_DRAIN) { const int lz = lane_id(); E.fused(acc, cur, wr, wc, lz & 15, lz >> 4, lds, wid, lz); }
#undef PG8_SA
#undef PG8_SB
#undef PG8_STAGE
#undef PG8_LDA
#undef PG8_LDB
#undef PG8_MMA
#undef PG8_WAIT_V
#undef PG8_WAIT_L
#undef PG8_BAR
#undef PG8_SCHED
}

struct EpiF32 {
    static constexpr bool PERM = false, AFTER_DRAIN = false;
    float* C; int ldc;
    DI void operator()(const f32x4 (&acc)[2][2][4][2], const Unit& u, int wr, int wc, int fr, int fq) const {
        const int row0 = u.pm * BM + wr * 64 + fr, col0 = u.pn * BM + wc * 32 + 4 * fq;
#pragma unroll
        for (int ai = 0; ai < 2; ++ai)
#pragma unroll
            for (int m = 0; m < 4; ++m) { float* rowp = C + (size_t)(row0 + ai * HALF + m * 16) * ldc + col0;
#pragma unroll
                for (int bj = 0; bj < 2; ++bj)
#pragma unroll
                    for (int n = 0; n < 2; ++n) *(f32x4*)(rowp + bj * HALF + n * 16) = acc[ai][bj][m][n]; }
    }
};
struct EpiBf16 {
    static constexpr bool PERM = true, AFTER_DRAIN = false;
    bf16_t* O; int ldc; BatchOff zo; int fl_tile; float* FL;
    DI void operator()(const f32x4 (&acc)[2][2][4][2], const Unit& u, int wr, int wc, int fr, int fq) const {
        const int row0 = u.pm * BM + wr * 64 + fr, col0 = u.pn * BM + wc * 32 + 8 * fq;
        bf16_t* base = O + zo.off(u.z);
#pragma unroll
        for (int ai = 0; ai < 2; ++ai)
#pragma unroll
            for (int m = 0; m < 4; ++m) { bf16_t* rowp = base + (size_t)(row0 + ai * HALF + m * 16) * ldc + col0;
#pragma unroll
                for (int bj = 0; bj < 2; ++bj) { const f32x4 v0 = acc[ai][bj][m][0], v1 = acc[ai][bj][m][1];
                    u32x4 w; w.x = pk2(v0[0], v0[1]); w.y = pk2(v0[2], v0[3]); w.z = pk2(v1[0], v1[1]); w.w = pk2(v1[2], v1[3]);
                    *(u32x4*)(rowp + bj * HALF) = w; } }
        if (u.pn == fl_tile && wc == 2 && fq < 2) {
#pragma unroll
            for (int ai = 0; ai < 2; ++ai)
#pragma unroll
                for (int m = 0; m < 4; ++m) { float* p = FL + (size_t)(row0 + ai * HALF + m * 16) * 16 + 8 * fq;
                    *(f32x4*)p = acc[ai][1][m][0]; *(f32x4*)(p + 4) = acc[ai][1][m][1]; }
        }
    }
};
struct EpiBf16R {
    static constexpr bool PERM = true, AFTER_DRAIN = false;
    bf16_t* O; int ldc; int fl_tile; float* FL; const float* rs;
    DI void operator()(const f32x4 (&acc)[2][2][4][2], const Unit& u, int wr, int wc, int fr, int fq) const {
        const int row0 = u.pm * BM + wr * 64 + fr, col0 = u.pn * BM + wc * 32 + 8 * fq;
#pragma unroll
        for (int ai = 0; ai < 2; ++ai)
#pragma unroll
            for (int m = 0; m < 4; ++m) { const int row = row0 + ai * HALF + m * 16; const float r = rs[row]; bf16_t* rowp = O + (size_t)row * ldc + col0;
#pragma unroll
                for (int bj = 0; bj < 2; ++bj) { const f32x4 v0 = acc[ai][bj][m][0] * r, v1 = acc[ai][bj][m][1] * r;
                    u32x4 w; w.x = pk2(v0[0], v0[1]); w.y = pk2(v0[2], v0[3]); w.z = pk2(v1[0], v1[1]); w.w = pk2(v1[2], v1[3]);
                    *(u32x4*)(rowp + bj * HALF) = w; }
                if (u.pn == fl_tile && wc == 2 && fq < 2) { float* p = FL + (size_t)row * 16 + 8 * fq; *(f32x4*)p = acc[ai][1][m][0] * r; *(f32x4*)(p + 4) = acc[ai][1][m][1] * r; } }
    }
};
struct EpiSwiGLU {
    static constexpr bool PERM = true, AFTER_DRAIN = false;
    bf16_t* O; int ldc; float sc;
    DI void operator()(const f32x4 (&acc)[2][2][4][2], const Unit& u, int wr, int wc, int fr, int fq) const {
        const int row0 = u.pm * BM + wr * 64 + fr, col0 = u.pn * HALF + wc * 32 + 8 * fq;
#pragma unroll
        for (int ai = 0; ai < 2; ++ai)
#pragma unroll
            for (int m = 0; m < 4; ++m) { float h[8];
#pragma unroll
                for (int n = 0; n < 2; ++n)
#pragma unroll
                    for (int j = 0; j < 4; ++j) { const float gt = acc[ai][0][m][n][j] * sc, up = acc[ai][1][m][n][j] * sc;
                        h[4 * n + j] = gt * __builtin_amdgcn_rcpf(1.0f + __builtin_amdgcn_exp2f(-gt * LOG2E)) * up; }
                u32x4 w; w.x = pk2(h[0], h[1]); w.y = pk2(h[2], h[3]); w.z = pk2(h[4], h[5]); w.w = pk2(h[6], h[7]);
                *(u32x4*)(O + (size_t)(row0 + ai * HALF + m * 16) * ldc + col0) = w; }
    }
};
struct EpiSwiGLU8 {
    static constexpr bool PERM = false, AFTER_DRAIN = false;
    unsigned char* O; int ldc; float sc;
    DI void operator()(const f32x4 (&acc)[2][2][4][2], const Unit& u, int wr, int wc, int fr, int fq) const {
        const int row0 = u.pm * BM + wr * 64 + fr, col0 = u.pn * HALF + wc * 32 + 4 * fq;
#pragma unroll
        for (int ai = 0; ai < 2; ++ai)
#pragma unroll
            for (int m = 0; m < 4; ++m)
#pragma unroll
                for (int n = 0; n < 2; ++n) { float h[4];
#pragma unroll
                    for (int j = 0; j < 4; ++j) { const float gt = acc[ai][0][m][n][j] * sc, up = acc[ai][1][m][n][j] * sc;
                        h[j] = __builtin_amdgcn_fmed3f(gt * __builtin_amdgcn_rcpf(1.0f + __builtin_amdgcn_exp2f(-gt * LOG2E)) * up * 16.0f, -448.0f, 448.0f); }
                    int w = __builtin_amdgcn_cvt_pk_fp8_f32(h[0], h[1], 0, false); w = __builtin_amdgcn_cvt_pk_fp8_f32(h[2], h[3], w, true);
                    *(unsigned*)(O + (size_t)(row0 + ai * HALF + m * 16) * ldc + col0 + 16 * n) = (unsigned)w; }
    }
};
struct EpiBf16S {
    static constexpr bool PERM = false, AFTER_DRAIN = false;
    bf16_t* O; int ldc; float sc;
    DI void operator()(const f32x4 (&acc)[2][2][4][2], const Unit& u, int wr, int wc, int fr, int fq) const {
        const int row0 = u.pm * BM + wr * 64 + fr, col0 = u.pn * BM + wc * 32 + 4 * fq;
#pragma unroll
        for (int ai = 0; ai < 2; ++ai)
#pragma unroll
            for (int m = 0; m < 4; ++m) { bf16_t* rowp = O + (size_t)(row0 + ai * HALF + m * 16) * ldc + col0;
#pragma unroll
                for (int bj = 0; bj < 2; ++bj)
#pragma unroll
                    for (int n = 0; n < 2; ++n) { const f32x4 v = acc[ai][bj][m][n] * sc; u32x2 w; w.x = pk2(v[0], v[1]); w.y = pk2(v[2], v[3]); *(u32x2*)(rowp + bj * HALF + n * 16) = w; } }
    }
};
template <int MODE> struct EpiLora {
    static constexpr bool PERM = true, AFTER_DRAIN = false;
    const float* vec; float* Of; bf16_t* Ob;
    DI void operator()(const f32x4 (&acc)[2][2][4][2], const Unit& u, int wr, int wc, int fr, int fq) const {
        const int row0 = u.pm * BM + wr * 64 + fr, col0 = u.pn * BM + wc * 32 + 8 * fq;
#pragma unroll
        for (int bj = 0; bj < 2; ++bj) {
            f32x4 b0 = (f32x4){0.f, 0.f, 0.f, 0.f}, b1 = b0;
            if (MODE < 2) { b0 = *(const f32x4*)(vec + col0 + bj * HALF); b1 = *(const f32x4*)(vec + col0 + bj * HALF + 4); }
#pragma unroll
            for (int ai = 0; ai < 2; ++ai)
#pragma unroll
                for (int m = 0; m < 4; ++m) { const size_t o = (size_t)(row0 + ai * HALF + m * 16) * RW + col0 + bj * HALF;
                    f32x4 v0 = acc[ai][bj][m][0] + b0, v1 = acc[ai][bj][m][1] + b1;
                    if (MODE == 2) { u32x4 w; w.x = pk2(v0[0], v0[1]); w.y = pk2(v0[2], v0[3]); w.z = pk2(v1[0], v1[1]); w.w = pk2(v1[2], v1[3]); *(u32x4*)(Ob + o) = w; }
                    else {
#pragma unroll
                        for (int j = 0; j < 4; ++j) {
                            if (MODE == 0) { v0[j] = __expf(-__expf(-(fmaxf(-v0[j], 0.f) + __logf(1.0f + __expf(-fabsf(v0[j])))) - 0.5f)); v1[j] = __expf(-__expf(-(fmaxf(-v1[j], 0.f) + __logf(1.0f + __expf(-fabsf(v1[j])))) - 0.5f)); }
                            else { v0[j] = 1.0f / (1.0f + __expf(-v0[j])); v1[j] = 1.0f / (1.0f + __expf(-v1[j])); } }
                        *(f32x4*)(Of + o) = v0; *(f32x4*)(Of + o + 4) = v1; } }
        }
    }
};
struct EpiSoftmax {
    static constexpr bool PERM = true, AFTER_DRAIN = true;
    bf16_t* P; float scale2;
    DI void fused(f32x4 (&acc)[2][2][4][2], const Unit& u, int wr, int wc, int fr, int fq, LAS unsigned char* lds, int wid, int lane) const {
        LAS float* PM = (LAS float*)lds;
        LAS float* PS = (LAS float*)(lds + 4096);
        float mx[2][4];
#pragma unroll
        for (int ai = 0; ai < 2; ++ai)
#pragma unroll
            for (int m = 0; m < 4; ++m) { float v = -3.0e38f;
#pragma unroll
                for (int bj = 0; bj < 2; ++bj)
#pragma unroll
                    for (int n = 0; n < 2; ++n)
#pragma unroll
                        for (int j = 0; j < 4; ++j) v = fmaxf(v, acc[ai][bj][m][n][j]);
                v = fmaxf(v, __shfl_xor(v, 16)); v = fmaxf(v, __shfl_xor(v, 32));
                if (fq == 0) PM[(ai * HALF + wr * 64 + m * 16 + fr) * 4 + wc] = v; }
        asm volatile("s_waitcnt lgkmcnt(0)" ::: "memory"); __builtin_amdgcn_s_barrier(); asm volatile("" ::: "memory");
#pragma unroll
        for (int ai = 0; ai < 2; ++ai)
#pragma unroll
            for (int m = 0; m < 4; ++m) { const int r = ai * HALF + wr * 64 + m * 16 + fr; const f32x4 pm = *(const LAS f32x4*)(PM + r * 4);
                const float mxv = fmaxf(fmaxf(pm[0], pm[1]), fmaxf(pm[2], pm[3])) * scale2; mx[ai][m] = mxv; float s = 0.f;
#pragma unroll
                for (int bj = 0; bj < 2; ++bj)
#pragma unroll
                    for (int n = 0; n < 2; ++n)
#pragma unroll
                        for (int j = 0; j < 4; ++j) { const float e = __builtin_amdgcn_exp2f(acc[ai][bj][m][n][j] * scale2 - mxv); acc[ai][bj][m][n][j] = e; s += e; }
                s += __shfl_xor(s, 16); s += __shfl_xor(s, 32);
                if (fq == 0) PS[r * 4 + wc] = s; }
        asm volatile("s_waitcnt lgkmcnt(0)" ::: "memory"); __builtin_amdgcn_s_barrier(); asm volatile("" ::: "memory");
        bf16_t* base = P + (size_t)u.z * SEQ * NMEM;
        const int col0 = wc * 32 + 8 * fq;
#pragma unroll
        for (int ai = 0; ai < 2; ++ai)
#pragma unroll
            for (int m = 0; m < 4; ++m) { const int r = ai * HALF + wr * 64 + m * 16 + fr; const f32x4 ps = *(const LAS f32x4*)(PS + r * 4);
                const float inv = 1.0f / ((ps[0] + ps[1]) + (ps[2] + ps[3]));
                bf16_t* rowp = base + (size_t)(u.pm * BM + r) * NMEM + col0;
#pragma unroll
                for (int bj = 0; bj < 2; ++bj) { const f32x4 v0 = acc[ai][bj][m][0] * inv, v1 = acc[ai][bj][m][1] * inv;
                    u32x4 w; w.x = pk2(v0[0], v0[1]); w.y = pk2(v0[2], v0[3]); w.z = pk2(v1[0], v1[1]); w.w = pk2(v1[2], v1[3]);
                    *(u32x4*)(rowp + bj * HALF) = w; } }
        (void)mx; (void)wid; (void)lane;
    }
};
}

#define XB_TMO      128
#define XB_XCNT(j)  (256  + 64 * (j))
#define XB_XSUB(j)  (1280 + 64 * (j))
#define XB_XGEN(j)  (2304 + 64 * (j))
#define XB_TOP      3328
#define XB_TOPGEN   3392
#define XCD_BAR_WORDS 3456
#define XB_SPIN_CAP (1u << 22)
DI unsigned xb_ld(unsigned* p)              { return __hip_atomic_load(p, __ATOMIC_RELAXED, __HIP_MEMORY_SCOPE_AGENT); }
DI unsigned xb_add(unsigned* p, unsigned v) { return __hip_atomic_fetch_add(p, v, __ATOMIC_RELAXED, __HIP_MEMORY_SCOPE_AGENT); }
DI unsigned xb_xcc_id() { return (unsigned)__builtin_amdgcn_s_getreg((3 << 11) | 20) & 0xFu; }
#define XB_SPIN(cond, bar) do { unsigned _sp = 0; while (cond) { __builtin_amdgcn_s_sleep(1); \
    if ((++_sp & 255u) == 0u) { if (xb_ld(&(bar)[XB_TMO])) break; if (_sp > XB_SPIN_CAP) { atomicAdd(&(bar)[XB_TMO], 1u); break; } } } } while (0)
struct XcdBarrier { unsigned* bar; unsigned x; volatile LAS unsigned* st; int wave; };
DI XcdBarrier xcd_barrier_post(unsigned* bar, volatile LAS unsigned* st, int wave) {
    XcdBarrier b; b.bar = bar; b.x = xb_xcc_id(); b.st = st; b.wave = wave;
    if (wave == 0 && lane_id() == 0) (void)xb_add(&bar[XB_XCNT(b.x)], 1u);
    return b;
}
DI void xcd_barrier_complete(unsigned* bar, unsigned x, unsigned& nloc, unsigned& nx) {
    const unsigned G = gridDim.x * gridDim.y * gridDim.z;
    unsigned sum, cnt, mine, sp = 0u;
    for (;;) {
        sum = 0u; cnt = 0u; mine = 0u;
#pragma unroll
        for (unsigned j = 0; j < 16; ++j) { const unsigned c = xb_ld(&bar[XB_XCNT(j)]); sum += c; cnt += (c > 0u) ? 1u : 0u; mine = (j == x) ? c : mine; }
        if (sum == G) break;
        __builtin_amdgcn_s_sleep(1);
        if ((++sp & 255u) == 0u) { if (xb_ld(&bar[XB_TMO])) break; if (sp > XB_SPIN_CAP) { atomicAdd(&bar[XB_TMO], 1u); break; } }
    }
    nloc = mine > 0u ? mine : 1u; nx = cnt > 0u ? cnt : 1u;
}
DI void xcd_barrier(const XcdBarrier& b) {
    asm volatile("s_waitcnt vmcnt(0)" ::: "memory");
    __syncthreads();
    if (b.wave == 0 && lane_id() == 0) {
        unsigned* bar = b.bar;
        __builtin_amdgcn_s_waitcnt(0);
        unsigned nloc = b.st[0], nx = b.st[1];
        if (nloc == 0u) { xcd_barrier_complete(bar, b.x, nloc, nx); b.st[0] = nloc; b.st[1] = nx; }
        const unsigned old = xb_add(&bar[XB_XSUB(b.x)], 1u);
        const unsigned gen = old / nloc;
        if (old + 1u == (gen + 1u) * nloc) {
            __builtin_amdgcn_fence(__ATOMIC_RELEASE, "agent");
            asm volatile("s_waitcnt vmcnt(0)" ::: "memory");
            const unsigned og = xb_add(&bar[XB_TOP], 1u);
            const unsigned tg = og / nx;
            if (og + 1u == (tg + 1u) * nx) xb_add(&bar[XB_TOPGEN], 1u);
            else XB_SPIN(xb_ld(&bar[XB_TOPGEN]) == tg, bar);
            __builtin_amdgcn_fence(__ATOMIC_ACQUIRE, "agent");
            xb_add(&bar[XB_XGEN(b.x)], 1u);
            asm volatile("s_waitcnt vmcnt(0)" ::: "memory");
        } else {
            XB_SPIN(xb_ld(&bar[XB_XGEN(b.x)]) == gen, bar);
            __builtin_amdgcn_fence(__ATOMIC_ACQUIRE, "agent");
            asm volatile("s_waitcnt vmcnt(0)" ::: "memory");
        }
    }
    __syncthreads();
}

constexpr int NWAVES = 8, NTHR = 512;
constexpr int RING_BYTES = 131072;
constexpr int LDS_BYTES = 147456;
constexpr int MISC_OFF = LDS_BYTES - 1024;
constexpr int CW_BAR = 4096;

struct Args { const float* in[35]; float* out; unsigned char* ws; int ph_lo, ph_hi; };
typedef const __attribute__((address_space(4))) Args CArgs;
enum { I_X = 0, I_MEM, I_F1PRE, I_F1G, I_F1U, I_F1D, I_F1POST, I_MIXPRE, I_WIN, I_FBIAS, I_MU, I_W0, I_WUP, I_A0, I_AUP, I_GUP, I_KK, I_KA, I_RK, I_LNW, I_LNB,
       I_WOUT, I_MIXPOST, I_XPRE, I_MEMG, I_WQ, I_WK, I_WV, I_WO, I_XPOST, I_F2PRE, I_F2G, I_F2U, I_F2D, I_F2POST };

DI float wave_sum(float v) {
#pragma unroll
    for (int o = 1; o < 64; o <<= 1) v += __shfl_xor(v, o);
    return v;
}

struct CvtJob { const float* W; const float* gk; int ldw, K, Kpad, col0, ncols; bf16* dst; int ldk, row0, mode, f8; };
DI void cvt_item(const CvtJob& J, int item, LAS float* scr, int lane) {
    const int nblk = (J.ncols + 63) >> 6, kb = item / nblk, nb = item - kb * nblk, k0 = kb * 64, n0 = nb * 64;
    const int nvalid = J.ncols - n0;
    const int c4 = lane & 15, kr = lane >> 4;
    f32x4 v[16];
    if (nvalid >= 64 && k0 + 64 <= J.K) {
        const GAS f32x4* src = (const GAS f32x4*)(J.W + (size_t)(k0 + kr) * J.ldw + J.col0 + n0 + 4 * c4); const size_t rs = (size_t)J.ldw;
#pragma unroll
        for (int i = 0; i < 16; ++i) v[i] = src[(size_t)i * rs];
    } else {
#pragma unroll
        for (int i = 0; i < 16; ++i) { const int k = k0 + 4 * i + kr;
            v[i] = (4 * c4 < nvalid && k < J.K) ? *(const GAS f32x4*)(J.W + (size_t)k * J.ldw + J.col0 + n0 + 4 * c4) : (f32x4){0.f, 0.f, 0.f, 0.f}; }
    }
    if (J.gk) {
#pragma unroll
        for (int i = 0; i < 16; ++i) { const int k = k0 + 4 * i + kr; const float gg = k < J.K ? J.gk[k] : 0.f; v[i] = v[i] * gg; } }
#pragma unroll
    for (int i = 0; i < 16; ++i) { const int k = 4 * i + kr; *(LAS f32x4*)(scr + k * 64 + ((4 * c4) ^ (((k >> 3) & 7) << 2))) = v[i]; }
    asm volatile("s_waitcnt lgkmcnt(0)" ::: "memory");
    if (J.f8) {
#pragma unroll
        for (int j = 0; j < 4; ++j) { const int p = j * 64 + lane, n = p >> 2, c = p & 3;
            unsigned o[4];
#pragma unroll
            for (int q = 0; q < 4; ++q) { const int e = 4 * q; const LAS float* sp = scr + (16 * c + e) * 64 + (n ^ ((2 * c + (e >> 3)) << 2));
                int w = __builtin_amdgcn_cvt_pk_fp8_f32(__builtin_amdgcn_fmed3f(sp[0] * 64.0f, -448.0f, 448.0f), __builtin_amdgcn_fmed3f(sp[64] * 64.0f, -448.0f, 448.0f), 0, false);
                w = __builtin_amdgcn_cvt_pk_fp8_f32(__builtin_amdgcn_fmed3f(sp[128] * 64.0f, -448.0f, 448.0f), __builtin_amdgcn_fmed3f(sp[192] * 64.0f, -448.0f, 448.0f), w, true); o[q] = (unsigned)w; }
            if (n < nvalid) { const int ng = n0 + n; const int drow = (J.mode == 0) ? (J.row0 + ng) : ((ng >> 7) * 256 + (ng & 127) + (J.mode == 2 ? 128 : 0));
                *(GAS u32x4*)((unsigned char*)J.dst + (size_t)drow * J.ldk + k0 + 16 * c) = (u32x4){o[0], o[1], o[2], o[3]}; } }
    } else {
#pragma unroll
    for (int j = 0; j < 8; ++j) { const int p = j * 64 + lane, n = p >> 3, c = p & 7;
        const LAS float* s = scr + (8 * c) * 64 + (n ^ (c << 2));
        u32x4 o; o.x = pk2(s[0], s[64]); o.y = pk2(s[128], s[192]); o.z = pk2(s[256], s[320]); o.w = pk2(s[384], s[448]);
        if (n < nvalid) { const int ng = n0 + n; const int drow = (J.mode == 0) ? (J.row0 + ng) : ((ng >> 7) * 256 + (ng & 127) + (J.mode == 2 ? 128 : 0));
            *(GAS u32x4*)(J.dst + (size_t)drow * J.ldk + k0 + 8 * c) = o; } }
    }
    asm volatile("s_waitcnt lgkmcnt(0)" ::: "memory");
}
constexpr int CI_FF = 64 * 172, CI_INA = 64 * 96, CI_INC = 64 * 7, CI_IND = 64, CI_SQ = 64 * 64, CI_LORA = 4 * 32;
constexpr int CVT_NITEMS = 6 * CI_FF + 2 * CI_INA + CI_INC + CI_IND + 5 * CI_SQ + 3 * CI_LORA;
constexpr int CVT_EARLY = 3 * CI_FF + 2 * CI_INA + CI_INC + CI_IND + 2 * CI_SQ + 3 * CI_LORA;
DI bool cvt_pick(CArgs& a, int it, CvtJob& J, int& local) {
    unsigned char* ws = a.ws;
#define CJ(cnt, Wp, ldw_, K_, Kpad_, col0_, ncols_, dst_, ldk_, row0_, mode_) \
    if (it < (cnt)) { J.W = (Wp); J.ldw = (ldw_); J.K = (K_); J.Kpad = (Kpad_); J.col0 = (col0_); J.ncols = (ncols_); J.dst = (bf16*)(ws + (dst_)); J.ldk = (ldk_); J.row0 = (row0_); J.mode = (mode_) & 3; J.f8 = ((mode_) >> 2) & 3; J.gk = ((mode_) >> 4) == 1 ? a.in[I_MIXPRE] : ((mode_) >> 4) == 2 ? a.in[I_XPRE] : nullptr; local = it; return true; } it -= (cnt);
    CJ(CI_FF, a.in[I_F1G], FF, D, D, 0, FF, WS_F1GU, D, 0, 1)
    CJ(CI_FF, a.in[I_F1U], FF, D, D, 0, FF, WS_F1GU, D, 0, 2)
    CJ(CI_FF, a.in[I_F1D], D, FF, FF, 0, D, WS_F1D, FF, 0, 0)
    CJ(CI_INA, a.in[I_WIN], IN_COLS, D, D, 0, 6144, WS_W_IN, D, 0, 0 + 16)
    CJ(CI_INA, a.in[I_WIN], IN_COLS, D, D, 6160, 6144, WS_W_IN, D, PC_RKV, 0 + 16)
    CJ(CI_INC, a.in[I_WIN], IN_COLS, D, D, 12304, 448, WS_W_IN, D, PC_LORA, 0 + 16)
    CJ(CI_IND, a.in[I_WIN], IN_COLS, D, D, 6144, 16, WS_W_IN, D, PC_FL, 0 + 16)
    CJ(CI_SQ, a.in[I_WK], D, D, D, 0, D, WS_WK, D, 0, 0)
    CJ(CI_SQ, a.in[I_WV], D, D, D, 0, D, WS_WV, D, 0, 0)
    CJ(CI_LORA, a.in[I_WUP], RW, 96, LORA_K, 0, RW, WS_LORAW, LORA_K, 0, 0)
    CJ(CI_LORA, a.in[I_AUP], RW, 96, LORA_K, 0, RW, WS_LORAW, LORA_K, RW, 0)
    CJ(CI_LORA, a.in[I_GUP], RW, 256, LORA_K, 0, RW, WS_LORAW, LORA_K, 2 * RW, 0)
    CJ(CI_SQ, a.in[I_WOUT], D, D, D, 0, D, WS_W_OUT, D, 0, 0)
    CJ(CI_SQ, a.in[I_WQ], D, D, D, 0, D, WS_WQ, D, 0, 0 + 32)
    CJ(CI_SQ, a.in[I_WO], D, D, D, 0, D, WS_WO, D, 0, 0)
    CJ(CI_FF, a.in[I_F2G], FF, D, D, 0, FF, WS_F2GU, D, 0, 1 + 4)
    CJ(CI_FF, a.in[I_F2U], FF, D, D, 0, FF, WS_F2GU, D, 0, 2 + 4)
    CJ(CI_FF, a.in[I_F2D], D, FF, FF, 0, D, WS_F2D, FF, 0, 0 + 4)
#undef CJ
    return false;
}
DI void rms_row_to_bf16(const float* xrow, const float* g, bf16* orow, int lane) {
    const GAS f32x4* xr = (const GAS f32x4*)xrow + lane; const GAS f32x4* gr = (const GAS f32x4*)g + lane;
    f32x4 v[16]; float s = 0.f;
#pragma unroll
    for (int j = 0; j < 16; ++j) { v[j] = xr[64 * j]; s += (v[j].x * v[j].x + v[j].y * v[j].y) + (v[j].z * v[j].z + v[j].w * v[j].w); }
    const float rstd = 1.0f / sqrtf(wave_sum(s) * (1.0f / D) + RMS_EPS);
    GAS u32x2* o8 = (GAS u32x2*)orow + lane;
#pragma unroll
    for (int j = 0; j < 16; ++j) { const f32x4 gg = gr[64 * j]; u32x2 w; w.x = pk2(v[j].x * rstd * gg.x, v[j].y * rstd * gg.y); w.y = pk2(v[j].z * rstd * gg.z, v[j].w * rstd * gg.w); o8[64 * j] = w; }
}
DI void p0_prologue(CArgs& a, LAS unsigned char* lds, int wave, int lane) {
    LAS float* scr = (LAS float*)(lds + wave * 16384);
    const int gw = blockIdx.x * NWAVES + wave, NGW = gridDim.x * NWAVES;
    if (P0_PARTS & 1) for (int it = CVT_LO + gw; it < CVT_HI; it += NGW) { CvtJob J; int local; if (cvt_pick(a, it, J, local)) cvt_item(J, local, scr, lane); }
    if (P0_PARTS & 2) { bf16* wi = (bf16*)(a.ws + WS_W_IN) + (size_t)12752 * D; const int nchunk = 48 * D / 8;
      for (int i = gw * 64 + lane; i < nchunk; i += NGW * 64) *(GAS u32x4*)(wi + (size_t)i * 8) = (u32x4){0u, 0u, 0u, 0u}; }
    bf16* H = (bf16*)(a.ws + WS_H); bf16* MEMN = (bf16*)(a.ws + WS_MEMN);
    if (P0_PARTS & 4) for (int m = gw; m < M; m += NGW) rms_row_to_bf16(a.in[I_X] + (size_t)m * D, a.in[I_F1PRE], H + (size_t)m * D, lane);
    if (P0_PARTS & 4) for (int m = gw; m < MM; m += NGW) rms_row_to_bf16(a.in[I_MEM] + (size_t)m * D, a.in[I_MEMG], MEMN + (size_t)m * D, lane);
}

DI void tail_cvt(CArgs& a, LAS unsigned char* lds, int wave, int lane, int first, int count, int r, int nidle) {
    LAS float* scr = (LAS float*)(lds + wave * 16384);
    for (int it = r * NWAVES + wave; it < count; it += nidle * NWAVES) { CvtJob J; int local; if (cvt_pick(a, first + it, J, local)) cvt_item(J, local, scr, lane); }
}
constexpr int CVT_TAIL = 6144;
template <bool H8, bool XIN32, bool XOUT32> DI void seam_phase(const void* xin_, const bf16* Y, void* xout_, bf16* H, const float* g_post, const float* g_pre, float alpha, int wave, int lane, float* rstd_out = nullptr, unsigned* tk = nullptr) {
    const int gw = blockIdx.x * NWAVES + wave, NGW = gridDim.x * NWAVES;
    const bool dyn = tk != nullptr; unsigned kn = 0;
    for (int m = gw, r = 0; m < M; ++r, m = (!dyn || r < 3) ? gw + r * NGW : 3 * NGW + (int)__builtin_amdgcn_readfirstlane((int)kn)) {
        if (dyn && r >= 2) { kn = 0; if (lane == 0) kn = atomicAdd(tk, 1u); }
        const GAS u32x4* yr = (const GAS u32x4*)(Y + (size_t)m * D) + lane;
        float y[8][8], x[8][8]; float s = 0.f;
#pragma unroll
        for (int j = 0; j < 8; ++j) { const u32x4 yy = yr[64 * j];
#pragma unroll
            for (int e = 0; e < 4; ++e) { y[j][2 * e] = bflo(yy[e]); y[j][2 * e + 1] = bfhi(yy[e]); } }
        if constexpr (XIN32) { const GAS f32x4* xr = (const GAS f32x4*)((const float*)xin_ + (size_t)m * D) + 2 * lane;
#pragma unroll
            for (int j = 0; j < 8; ++j) { const f32x4 a0 = xr[128 * j], a1 = xr[128 * j + 1]; x[j][0] = a0[0]; x[j][1] = a0[1]; x[j][2] = a0[2]; x[j][3] = a0[3]; x[j][4] = a1[0]; x[j][5] = a1[1]; x[j][6] = a1[2]; x[j][7] = a1[3]; } }
        else { const GAS u32x4* xr = (const GAS u32x4*)((const bf16*)xin_ + (size_t)m * D) + lane;
#pragma unroll
            for (int j = 0; j < 8; ++j) { const u32x4 xx = xr[64 * j];
#pragma unroll
                for (int e = 0; e < 4; ++e) { x[j][2 * e] = bflo(xx[e]); x[j][2 * e + 1] = bfhi(xx[e]); } } }
#pragma unroll
        for (int j = 0; j < 8; ++j)
#pragma unroll
            for (int e = 0; e < 8; ++e) s += y[j][e] * y[j][e];
        const float ry = alpha / sqrtf(wave_sum(s) * (1.0f / D) + RMS_EPS);
        float s2 = 0.f; const GAS f32x4* gp = (const GAS f32x4*)g_post + 2 * lane;
#pragma unroll
        for (int j = 0; j < 8; ++j) { const f32x4 g0 = gp[128 * j], g1 = gp[128 * j + 1];
#pragma unroll
            for (int e = 0; e < 8; ++e) { const float gg = (e < 4) ? g0[e] : g1[e - 4]; x[j][e] = x[j][e] + y[j][e] * ry * gg; s2 += x[j][e] * x[j][e]; }
            if constexpr (XOUT32) { GAS f32x4* xo = (GAS f32x4*)((float*)xout_ + (size_t)m * D) + 2 * lane; xo[128 * j] = (f32x4){x[j][0], x[j][1], x[j][2], x[j][3]}; xo[128 * j + 1] = (f32x4){x[j][4], x[j][5], x[j][6], x[j][7]}; }
            else { u32x4 w; w.x = pk2(x[j][0], x[j][1]); w.y = pk2(x[j][2], x[j][3]); w.z = pk2(x[j][4], x[j][5]); w.w = pk2(x[j][6], x[j][7]); ((GAS u32x4*)((bf16*)xout_ + (size_t)m * D) + lane)[64 * j] = w; } }
        if (g_pre) {
            const float rx = 1.0f / sqrtf(wave_sum(s2) * (1.0f / D) + RMS_EPS);
            if (rstd_out) { if (lane == 0) rstd_out[m] = rx; continue; }
            const GAS f32x4* gq = (const GAS f32x4*)g_pre + 2 * lane;
#pragma unroll
            for (int j = 0; j < 8; ++j) { const f32x4 g0 = gq[128 * j], g1 = gq[128 * j + 1]; float hv[8];
#pragma unroll
                for (int e = 0; e < 8; ++e) hv[e] = x[j][e] * rx * ((e < 4) ? g0[e] : g1[e - 4]);
                if constexpr (H8) {
#pragma unroll
                    for (int e = 0; e < 8; ++e) hv[e] = __builtin_amdgcn_fmed3f(hv[e] * 8.0f, -448.0f, 448.0f);
                    int w0 = __builtin_amdgcn_cvt_pk_fp8_f32(hv[0], hv[1], 0, false); w0 = __builtin_amdgcn_cvt_pk_fp8_f32(hv[2], hv[3], w0, true);
                    int w1 = __builtin_amdgcn_cvt_pk_fp8_f32(hv[4], hv[5], 0, false); w1 = __builtin_amdgcn_cvt_pk_fp8_f32(hv[6], hv[7], w1, true);
                    ((GAS u32x2*)((unsigned char*)H + (size_t)m * D) + lane)[64 * j] = (u32x2){(unsigned)w0, (unsigned)w1};
                } else { u32x4 w; w.x = pk2(hv[0], hv[1]); w.y = pk2(hv[2], hv[3]); w.z = pk2(hv[4], hv[5]); w.w = pk2(hv[6], hv[7]); ((GAS u32x4*)(H + (size_t)m * D) + lane)[64 * j] = w; } }
        }
    }
}

DI float fox_logsig(float z) { return (z >= 0.f) ? -log1pf(expf(-z)) : (z - log1pf(expf(z))); }
DI void fox_cumsum_phase(CArgs& a, LAS unsigned char* lds, int wave, int lane) {
    const float* FL = (const float*)(a.ws + WS_FL); float* C = (float*)(a.ws + WS_C);
    LAS float* red = (LAS float*)lds;
    const int tid_ = wave * 64 + lane;
    for (int u = blockIdx.x; u < BATCH * FOXH * 4; u += gridDim.x) {
        const int bh = u >> 2, seg = u & 3, b = bh >> 4, h = bh & 15; const float bias = a.in[I_FBIAS][h];
        const float* fl = FL + (size_t)b * SEQ * 16 + h;
        const float own = fox_logsig(fl[(size_t)(512 * seg + tid_) * 16] + bias);
        float before = 0.f;
        for (int s = 0; s < seg; ++s) before += fox_logsig(fl[(size_t)(512 * s + tid_) * 16] + bias);
        float incl = own;
#pragma unroll
        for (int o = 1; o < 64; o <<= 1) { const float t = __shfl_up(incl, o); if (lane >= o) incl += t; }
        float bsum = before;
#pragma unroll
        for (int o = 32; o > 0; o >>= 1) bsum += __shfl_xor(bsum, o);
        __syncthreads();
        if (lane == 63) red[wave] = incl;
        if (lane == 0) red[8 + wave] = bsum;
        __syncthreads();
        float off = 0.f;
#pragma unroll
        for (int w = 0; w < 8; ++w) { off += red[8 + w]; if (w < wave) off += red[w]; }
        C[(size_t)bh * SEQ + 512 * seg + tid_] = (off + incl) * LOG2E;
    }
}
DI void lora_act_phase(CArgs& a, int wave, int lane) {
    const int gw = blockIdx.x * NWAVES + wave, NGW = gridDim.x * NWAVES;
    const bf16* PROJ = (const bf16*)(a.ws + WS_BIG); bf16* AL = (bf16*)(a.ws + WS_ALORA); const float* mu = a.in[I_MU] + 6144;
    for (int m = gw; m < M; m += NGW) {
        const bool has_prev = (m & (SEQ - 1)) != 0; const bf16* cur = PROJ + (size_t)m * NIN + PC_LORA; bf16* o = AL + (size_t)m * ALD;
        if (lane < 56) {
            const int j = 8 * lane; const u32x4 c4 = *(const GAS u32x4*)(cur + j); u32x4 p4 = (u32x4){0u, 0u, 0u, 0u}; if (has_prev) p4 = *(const GAS u32x4*)(cur + j - NIN);
            const f32x4 m0 = *(const GAS f32x4*)(mu + j), m1 = *(const GAS f32x4*)(mu + j + 4);
            float z[8];
#pragma unroll
            for (int e = 0; e < 4; ++e) { const float c0 = bflo(c4[e]), c1 = bfhi(c4[e]), p0 = bflo(p4[e]), p1 = bfhi(p4[e]); const float mm0 = (e < 2) ? m0[2 * e] : m1[2 * e - 4], mm1 = (e < 2) ? m0[2 * e + 1] : m1[2 * e - 3];
                z[2 * e] = c0 + mm0 * (p0 - c0); z[2 * e + 1] = c1 + mm1 * (p1 - c1); }
            int dst;
            if (lane < 12) { dst = j;
#pragma unroll
                for (int e = 0; e < 8; ++e) z[e] = tanhf(z[e]); }
            else if (lane < 24) dst = 256 + (j - 96);
            else { dst = 512 + (j - 192);
#pragma unroll
                for (int e = 0; e < 8; ++e) z[e] = 1.0f / (1.0f + __expf(-z[e])); }
            u32x4 w; w.x = pk2(z[0], z[1]); w.y = pk2(z[2], z[3]); w.z = pk2(z[4], z[5]); w.w = pk2(z[6], z[7]); *(GAS u32x4*)(o + dst) = w;
        }
        if (lane < 40) { const int dst = (lane < 20) ? (96 + 8 * lane) : (352 + 8 * (lane - 20)); *(GAS u32x4*)(o + dst) = (u32x4){0u, 0u, 0u, 0u}; }
    }
}
DI float lane8_sum(float x) {
    x += __builtin_bit_cast(float, __builtin_amdgcn_update_dpp(0, __builtin_bit_cast(int, x), 0xB1, 0xf, 0xf, false));
    x += __builtin_bit_cast(float, __builtin_amdgcn_update_dpp(0, __builtin_bit_cast(int, x), 0x4E, 0xf, 0xf, false));
    x += __builtin_bit_cast(float, __builtin_amdgcn_update_dpp(0, __builtin_bit_cast(int, x), 0x141, 0xf, 0xf, false));
    return x;
}
DI void rwkv_post_phase(CArgs& a, int wave, int lane) {
    const int gw = blockIdx.x * NWAVES + wave, NGW = gridDim.x * NWAVES;
    const float* YR = (const float*)(a.ws + WS_YR); const bf16* PROJ = (const bf16*)(a.ws + WS_BIG); const bf16* G_ = (const bf16*)(a.ws + WS_G); const float* BON = (const float*)(a.ws + WS_BON);
    bf16* MIX = (bf16*)(a.ws + WS_ACT2);
    for (int task = gw; task < M * 4; task += NGW) {
        const int m = task >> 2, c = (task & 3) * 512 + 8 * lane, h = c >> 6; const bool has_prev = (m & (SEQ - 1)) != 0;
        const f32x4 y0 = *(const GAS f32x4*)(YR + (size_t)m * RW + c), y1 = *(const GAS f32x4*)(YR + (size_t)m * RW + c + 4);
        const bf16* pv = PROJ + (size_t)m * NIN + PC_RKV + 4096 + c;
        const u32x4 vc = *(const GAS u32x4*)pv; u32x4 vp = (u32x4){0u, 0u, 0u, 0u}; if (has_prev) vp = *(const GAS u32x4*)(pv - NIN);
        const u32x4 gg = *(const GAS u32x4*)(G_ + (size_t)m * RW + c);
        const float bon = BON[(size_t)m * RH + h];
        const f32x4 mu0 = *(const GAS f32x4*)(a.in[I_MU] + 4096 + c), mu1 = *(const GAS f32x4*)(a.in[I_MU] + 4096 + c + 4);
        const f32x4 lw0 = *(const GAS f32x4*)(a.in[I_LNW] + c), lw1 = *(const GAS f32x4*)(a.in[I_LNW] + c + 4), lb0 = *(const GAS f32x4*)(a.in[I_LNB] + c), lb1 = *(const GAS f32x4*)(a.in[I_LNB] + c + 4);
        float y[8] = {y0[0], y0[1], y0[2], y0[3], y1[0], y1[1], y1[2], y1[3]};
        float s = 0.f;
#pragma unroll
        for (int e = 0; e < 8; ++e) s += y[e];
        const float mean = lane8_sum(s) * (1.0f / 64.0f); float q = 0.f;
#pragma unroll
        for (int e = 0; e < 8; ++e) { y[e] -= mean; q += y[e] * y[e]; }
        const float rstd = 1.0f / sqrtf(lane8_sum(q) * (1.0f / 64.0f) + GN_EPS);
        float o[8];
#pragma unroll
        for (int e = 0; e < 8; ++e) { const float vcur = (e & 1) ? bfhi(vc[e >> 1]) : bflo(vc[e >> 1]), vprev = (e & 1) ? bfhi(vp[e >> 1]) : bflo(vp[e >> 1]);
            const float mue = (e < 4) ? mu0[e] : mu1[e - 4], lwe = (e < 4) ? lw0[e] : lw1[e - 4], lbe = (e < 4) ? lb0[e] : lb1[e - 4];
            const float v = vcur + mue * (vprev - vcur); const float ge = (e & 1) ? bfhi(gg[e >> 1]) : bflo(gg[e >> 1]);
            o[e] = (y[e] * rstd * lwe + lbe + bon * v) * ge; }
        u32x4 w; w.x = pk2(o[0], o[1]); w.y = pk2(o[2], o[3]); w.z = pk2(o[4], o[5]); w.w = pk2(o[6], o[7]);
        *(GAS u32x4*)(MIX + (size_t)m * D + RW + c) = w;
    }
}

DI float row16_sum(float x) {
    x += __builtin_bit_cast(float, __builtin_amdgcn_update_dpp(0, __builtin_bit_cast(int, x), 0x128, 0xf, 0xf, false));
    x += __builtin_bit_cast(float, __builtin_amdgcn_update_dpp(0, __builtin_bit_cast(int, x), 0x124, 0xf, 0xf, false));
    x += __builtin_bit_cast(float, __builtin_amdgcn_update_dpp(0, __builtin_bit_cast(int, x), 0x122, 0xf, 0xf, false));
    x += __builtin_bit_cast(float, __builtin_amdgcn_update_dpp(0, __builtin_bit_cast(int, x), 0x121, 0xf, 0xf, false));
    return x;
}
DI float row8_sum(float x) {
    x += __builtin_bit_cast(float, __builtin_amdgcn_update_dpp(0, __builtin_bit_cast(int, x), 0x141, 0xf, 0xf, false));
    x += __builtin_bit_cast(float, __builtin_amdgcn_update_dpp(0, __builtin_bit_cast(int, x), 0x1B, 0xf, 0xf, false));
    x += __builtin_bit_cast(float, __builtin_amdgcn_update_dpp(0, __builtin_bit_cast(int, x), 0xB1, 0xf, 0xf, false));
    return x;
}
constexpr int SC_T = 16;
constexpr int SC_R = 0, SC_W = 4096, SC_KM = 8192, SC_KK = 12288, SC_KKA = 16384, SC_V = 20480, SC_BUF = 22528 + 512;
constexpr int SC_YB = 3 * SC_BUF, SC_CVT = 73728;
static_assert(SC_YB + 2 * 2048 <= SC_CVT && SC_CVT + 4 * 16384 <= MISC_OFF, "scan LDS map");
DI void fox4_run(CArgs& a, int u, LAS unsigned char* lds, volatile LAS unsigned* cnt, unsigned& target, int w4, int lane);
DI void scan_unit(CArgs& a, int unit, bool do_cvt, LAS unsigned char* lds, volatile LAS unsigned* cntw, int tid, int wave, int lane) {
    const unsigned cbase = *cntw; const unsigned cbase2 = cntw[4];
    __syncthreads();
    if (wave >= 4) {
        if (do_cvt) { LAS float* scr = (LAS float*)(lds + SC_CVT + (wave - 4) * 16384); const int cw = blockIdx.x * 4 + (wave - 4), NCW = gridDim.x * 4;
            for (int it = CVT_EARLY + (gridDim.x == 256 ? 2 * CVT_TAIL : 0) + cw; it < CVT_NITEMS; it += NCW) { CvtJob J; int local; if (cvt_pick(a, it, J, local)) cvt_item(J, local, scr, lane); }
            __builtin_amdgcn_s_setprio(FOX_PRIO); unsigned tgt2 = cbase2; for (int fu = blockIdx.x; fu < 256; fu += gridDim.x) fox4_run(a, fu, lds, cntw + 4, tgt2, wave - 4, lane); __builtin_amdgcn_s_setprio(0); }
    } else {
    __builtin_amdgcn_s_setprio(3);
    const int half = unit & 1, bh = unit >> 1, b = bh >> 5, h = bh & 31;
    const bf16* PROJ = (const bf16*)(a.ws + WS_BIG); const float* AA = (const float*)(a.ws + WS_AA); const float* WD = (const float*)(a.ws + WS_WDEC);
    float* YR = (float*)(a.ws + WS_YR); float* BON = (float*)(a.ws + WS_BON);
    const int rp = lane >> 4, g = lane & 15, rowA = 8 * wave + 2 * rp;
    unsigned target = cbase;
#define SC_ARRIVE() do { asm volatile("s_waitcnt lgkmcnt(0)" ::: "memory"); if (lane == 0) __hip_atomic_fetch_add((LAS unsigned*)cntw, 1u, __ATOMIC_RELAXED, __HIP_MEMORY_SCOPE_WORKGROUP); target += 4u; } while (0)
#define SC_WAIT() do { while ((int)(__hip_atomic_load((LAS unsigned*)cntw, __ATOMIC_RELAXED, __HIP_MEMORY_SCOPE_WORKGROUP) - target) < 0) { } asm volatile("" ::: "memory"); } while (0)
#define SC_BAR() do { asm volatile("s_waitcnt lgkmcnt(0)" ::: "memory"); if (lane == 0) __hip_atomic_fetch_add((LAS unsigned*)cntw, 1u, __ATOMIC_RELAXED, __HIP_MEMORY_SCOPE_WORKGROUP); target += 4u; \
        while ((int)(__hip_atomic_load((LAS unsigned*)cntw, __ATOMIC_RELAXED, __HIP_MEMORY_SCOPE_WORKGROUP) - target) < 0) { } asm volatile("" ::: "memory"); } while (0)
    const int st = tid >> 4, c4 = h * 64 + 4 * g;
    const bf16* gP = PROJ + (size_t)(b * SEQ + st) * NIN + PC_RKV + c4; const float* gA = AA + (size_t)(b * SEQ + st) * RW + c4; const float* gW = WD + (size_t)(b * SEQ + st) * RW + c4;
    const f32x4 mur = *(const GAS f32x4*)(a.in[I_MU] + c4), muk = *(const GAS f32x4*)(a.in[I_MU] + 2048 + c4), muv = *(const GAS f32x4*)(a.in[I_MU] + 4096 + c4);
    const f32x4 pkk = *(const GAS f32x4*)(a.in[I_KK] + c4), pka = *(const GAS f32x4*)(a.in[I_KA] + c4), prk = *(const GAS f32x4*)(a.in[I_RK] + c4);
    u32x2 rc, kc, vc, rp_, kp, vp; f32x4 av, wv;
#define SC_LOAD(ck) do { const size_t _o = (size_t)(ck) * SC_T; const bf16* _p = gP + _o * NIN; rc = *(const GAS u32x2*)_p; kc = *(const GAS u32x2*)(_p + 2048); vc = *(const GAS u32x2*)(_p + 4096); \
        if ((ck) * SC_T + st > 0) { rp_ = *(const GAS u32x2*)(_p - NIN); kp = *(const GAS u32x2*)(_p - NIN + 2048); vp = *(const GAS u32x2*)(_p - NIN + 4096); } else { rp_ = (u32x2){0u, 0u}; kp = rp_; vp = rp_; } \
        av = *(const GAS f32x4*)(gA + _o * RW); wv = *(const GAS f32x4*)(gW + _o * RW); } while (0)
#define SC_UNP(u) ((f32x4){bflo((u).x), bfhi((u).x), bflo((u).y), bfhi((u).y)})
#define SC_STORE(bufo, ck) do { \
        f32x4 r = SC_UNP(rc), k = SC_UNP(kc), v = SC_UNP(vc); r = r + mur * (SC_UNP(rp_) - r); k = k + muk * (SC_UNP(kp) - k); v = v + muv * (SC_UNP(vp) - v); \
        f32x4 kk = k * pkk; const float n2 = row16_sum((kk.x * kk.x + kk.y * kk.y) + (kk.z * kk.z + kk.w * kk.w)); kk = kk * __builtin_amdgcn_rsqf(fmaxf(n2, 1e-24f)); \
        const f32x4 km = k * (1.0f + (av - 1.0f) * pka); const f32x4 rk = r * km * prk; const float bon = row16_sum((rk.x + rk.y) + (rk.z + rk.w)); \
        LAS unsigned char* _b = lds + (bufo) + st * 256 + g * 16; \
        *(LAS f32x4*)(_b + SC_R) = r; *(LAS f32x4*)(_b + SC_W) = wv; *(LAS f32x4*)(_b + SC_KM) = km; *(LAS f32x4*)(_b + SC_KK) = kk; *(LAS f32x4*)(_b + SC_KKA) = kk * av; \
        if ((g >> 3) == half) *(LAS f32x4*)(lds + (bufo) + SC_V + st * 128 + (g & 7) * 16) = v; \
        if (g == 0 && half == 0) BON[(size_t)(b * SEQ + (ck) * SC_T + st) * RH + h] = bon; } while (0)
    const int rq = lane >> 3, g8 = lane & 7, rowQ = 8 * wave + rq;
    float s0 = 0.f, s1 = 0.f, s2 = 0.f, s3 = 0.f, s4 = 0.f, s5 = 0.f, s6 = 0.f, s7 = 0.f;
    constexpr int NCH = SEQ / SC_T;
    SC_LOAD(0); SC_STORE(0, 0); SC_LOAD(1);
    SC_BAR();
    int bcur = 0;
    for (int ck = 0; ck < NCH; ++ck) {
        const int bo = bcur * SC_BUF; const int bnext = (bcur == 2) ? 0 : bcur + 1;
        if (ck + 1 < NCH) { SC_STORE(bnext * SC_BUF, ck + 1); if (ck + 2 < NCH) SC_LOAD(ck + 2); }
        SC_ARRIVE();
        const LAS unsigned char* bp = lds + bo + g8 * 32; const LAS unsigned char* vp_ = lds + bo + SC_V + rowQ * 4; LAS unsigned char* yb = lds + SC_YB + (ck & 1) * 2048 + rowQ * 4;
#define SC_LD(P, t) do { P##kk0 = *(const LAS f32x4*)(bp + SC_KK + (t) * 256); P##kk1 = *(const LAS f32x4*)(bp + SC_KK + (t) * 256 + 16); P##w0 = *(const LAS f32x4*)(bp + SC_W + (t) * 256); P##w1 = *(const LAS f32x4*)(bp + SC_W + (t) * 256 + 16); \
        P##ka0 = *(const LAS f32x4*)(bp + SC_KKA + (t) * 256); P##ka1 = *(const LAS f32x4*)(bp + SC_KKA + (t) * 256 + 16); P##km0 = *(const LAS f32x4*)(bp + SC_KM + (t) * 256); P##km1 = *(const LAS f32x4*)(bp + SC_KM + (t) * 256 + 16); \
        P##r0 = *(const LAS f32x4*)(bp + SC_R + (t) * 256); P##r1 = *(const LAS f32x4*)(bp + SC_R + (t) * 256 + 16); P##v = *(const LAS float*)(vp_ + (t) * 128); } while (0)
#define SC_MUL(d, x, y) asm("v_mul_f32 %0, %1, %2" : "=v"(d) : "v"(x), "v"(y))
#define SC_FMA(d, x, y, z) asm("v_fma_f32 %0, %1, %2, %3" : "=v"(d) : "v"(x), "v"(y), "v"(z))
#define SC_FNMA(d, x, y, z) asm("v_fma_f32 %0, -%1, %2, %3" : "=v"(d) : "v"(x), "v"(y), "v"(z))
#define SC_RED1(P) asm volatile( \
        "v_add_f32 %[d], %[m0], %[m1]\n\tv_mul_f32 %[t0], %[k0], %[v]\n\tv_mul_f32 %[t1], %[k1], %[v]\n\tv_mul_f32 %[t2], %[k2], %[v]\n\tv_mul_f32 %[t3], %[k3], %[v]\n\t" \
        "v_add_f32_dpp %[d], %[d], %[d] row_half_mirror row_mask:0xf bank_mask:0xf\n\tv_mul_f32 %[t4], %[k4], %[v]\n\tv_mul_f32 %[t5], %[k5], %[v]\n\t" \
        "v_add_f32_dpp %[d], %[d], %[d] quad_perm:[3,2,1,0] row_mask:0xf bank_mask:0xf\n\tv_mul_f32 %[t6], %[k6], %[v]\n\tv_mul_f32 %[t7], %[k7], %[v]\n\t" \
        "v_add_f32_dpp %[d], %[d], %[d] quad_perm:[1,0,3,2] row_mask:0xf bank_mask:0xf" \
        : [d] "=&v"(dA), [t0] "=&v"(t0), [t1] "=&v"(t1), [t2] "=&v"(t2), [t3] "=&v"(t3), [t4] "=&v"(t4), [t5] "=&v"(t5), [t6] "=&v"(t6), [t7] "=&v"(t7) \
        : [m0] "v"(m0), [m1] "v"(m1), [v] "v"(P##v), [k0] "v"(P##km0.x), [k1] "v"(P##km0.y), [k2] "v"(P##km0.z), [k3] "v"(P##km0.w), [k4] "v"(P##km1.x), [k5] "v"(P##km1.y), [k6] "v"(P##km1.z), [k7] "v"(P##km1.w))
#define SC_RED2(N) asm volatile( \
        "v_add_f32 %[y], %[a0], %[a1]\n\tv_mul_f32 %[n0], %[s0], %[q0]\n\tv_mul_f32 %[n1], %[s4], %[q4]\n\t" \
        "v_add_f32_dpp %[y], %[y], %[y] row_half_mirror row_mask:0xf bank_mask:0xf\n\tv_fma_f32 %[n0], %[s1], %[q1], %[n0]\n\tv_fma_f32 %[n1], %[s5], %[q5], %[n1]\n\t" \
        "v_add_f32_dpp %[y], %[y], %[y] quad_perm:[3,2,1,0] row_mask:0xf bank_mask:0xf\n\tv_fma_f32 %[n0], %[s2], %[q2], %[n0]\n\tv_fma_f32 %[n1], %[s6], %[q6], %[n1]\n\t" \
        "v_add_f32_dpp %[y], %[y], %[y] quad_perm:[1,0,3,2] row_mask:0xf bank_mask:0xf\n\tv_fma_f32 %[n0], %[s3], %[q3], %[n0]\n\tv_fma_f32 %[n1], %[s7], %[q7], %[n1]" \
        : [y] "=&v"(yA), [n0] "=&v"(m0), [n1] "=&v"(m1) \
        : [a0] "v"(y0), [a1] "v"(y1), [s0] "v"(s0), [s1] "v"(s1), [s2] "v"(s2), [s3] "v"(s3), [s4] "v"(s4), [s5] "v"(s5), [s6] "v"(s6), [s7] "v"(s7), \
          [q0] "v"(N##kk0.x), [q1] "v"(N##kk0.y), [q2] "v"(N##kk0.z), [q3] "v"(N##kk0.w), [q4] "v"(N##kk1.x), [q5] "v"(N##kk1.y), [q6] "v"(N##kk1.z), [q7] "v"(N##kk1.w))
#define SC_RED2L() asm volatile( \
        "v_add_f32 %[y], %[a0], %[a1]\n\ts_nop 1\n\tv_add_f32_dpp %[y], %[y], %[y] row_half_mirror row_mask:0xf bank_mask:0xf\n\ts_nop 1\n\t" \
        "v_add_f32_dpp %[y], %[y], %[y] quad_perm:[3,2,1,0] row_mask:0xf bank_mask:0xf\n\ts_nop 1\n\tv_add_f32_dpp %[y], %[y], %[y] quad_perm:[1,0,3,2] row_mask:0xf bank_mask:0xf" \
        : [y] "=&v"(yA) : [a0] "v"(y0), [a1] "v"(y1))
#define SC_PART(P) do { SC_MUL(m0, s0, P##kk0.x); SC_MUL(m1, s4, P##kk1.x); SC_FMA(m0, s1, P##kk0.y, m0); SC_FMA(m1, s5, P##kk1.y, m1); \
        SC_FMA(m0, s2, P##kk0.z, m0); SC_FMA(m1, s6, P##kk1.z, m1); SC_FMA(m0, s3, P##kk0.w, m0); SC_FMA(m1, s7, P##kk1.w, m1); } while (0)
#define SC_UPD1(P) asm volatile( \
        "v_fma_f32 %[s0], %[s0], %[w0], %[t0]\n\tv_fma_f32 %[s1], %[s1], %[w1], %[t1]\n\tv_fma_f32 %[s2], %[s2], %[w2], %[t2]\n\tv_fma_f32 %[s3], %[s3], %[w3], %[t3]\n\t" \
        "v_fma_f32 %[s4], %[s4], %[w4], %[t4]\n\tv_fma_f32 %[s5], %[s5], %[w5], %[t5]\n\tv_fma_f32 %[s6], %[s6], %[w6], %[t6]\n\tv_fma_f32 %[s7], %[s7], %[w7], %[t7]" \
        : [s0] "+v"(s0), [s1] "+v"(s1), [s2] "+v"(s2), [s3] "+v"(s3), [s4] "+v"(s4), [s5] "+v"(s5), [s6] "+v"(s6), [s7] "+v"(s7) \
        : [t0] "v"(t0), [t1] "v"(t1), [t2] "v"(t2), [t3] "v"(t3), [t4] "v"(t4), [t5] "v"(t5), [t6] "v"(t6), [t7] "v"(t7), \
          [w0] "v"(P##w0.x), [w1] "v"(P##w0.y), [w2] "v"(P##w0.z), [w3] "v"(P##w0.w), [w4] "v"(P##w1.x), [w5] "v"(P##w1.y), [w6] "v"(P##w1.z), [w7] "v"(P##w1.w))
#define SC_UPD2(P) asm volatile( \
        "v_fma_f32 %[s0], -%[d], %[a0], %[s0]\n\tv_fma_f32 %[s4], -%[d], %[a4], %[s4]\n\tv_fma_f32 %[s1], -%[d], %[a1], %[s1]\n\tv_fma_f32 %[s5], -%[d], %[a5], %[s5]\n\t" \
        "v_fma_f32 %[s2], -%[d], %[a2], %[s2]\n\tv_fma_f32 %[s6], -%[d], %[a6], %[s6]\n\tv_fma_f32 %[s3], -%[d], %[a3], %[s3]\n\tv_fma_f32 %[s7], -%[d], %[a7], %[s7]\n\t" \
        "v_mul_f32 %[y0], %[s0], %[r0]\n\tv_mul_f32 %[y1], %[s4], %[r4]\n\tv_fma_f32 %[y0], %[s1], %[r1], %[y0]\n\tv_fma_f32 %[y1], %[s5], %[r5], %[y1]\n\t" \
        "v_fma_f32 %[y0], %[s2], %[r2], %[y0]\n\tv_fma_f32 %[y1], %[s6], %[r6], %[y1]\n\tv_fma_f32 %[y0], %[s3], %[r3], %[y0]\n\tv_fma_f32 %[y1], %[s7], %[r7], %[y1]" \
        : [s0] "+v"(s0), [s1] "+v"(s1), [s2] "+v"(s2), [s3] "+v"(s3), [s4] "+v"(s4), [s5] "+v"(s5), [s6] "+v"(s6), [s7] "+v"(s7), [y0] "=&v"(y0), [y1] "=&v"(y1) \
        : [d] "v"(dA), [a0] "v"(P##ka0.x), [a1] "v"(P##ka0.y), [a2] "v"(P##ka0.z), [a3] "v"(P##ka0.w), [a4] "v"(P##ka1.x), [a5] "v"(P##ka1.y), [a6] "v"(P##ka1.z), [a7] "v"(P##ka1.w), \
          [r0] "v"(P##r0.x), [r1] "v"(P##r0.y), [r2] "v"(P##r0.z), [r3] "v"(P##r0.w), [r4] "v"(P##r1.x), [r5] "v"(P##r1.y), [r6] "v"(P##r1.z), [r7] "v"(P##r1.w))
#define SC_BODY(P) float dA, t0, t1, t2, t3, t4, t5, t6, t7, y0, y1, yA; \
        SC_RED1(P); SC_UPD1(P); SC_UPD2(P);
#define SC_STEP_M(P, N, t) do { SC_BODY(P) SC_RED2(N); *(LAS float*)(yb + (t) * 128) = yA; } while (0)
#define SC_STEP_L(P, t) do { SC_BODY(P) SC_RED2L(); *(LAS float*)(yb + (t) * 128) = yA; } while (0)
        f32x4 p0kk0, p0kk1, p0w0, p0w1, p0ka0, p0ka1, p0km0, p0km1, p0r0, p0r1, p1kk0, p1kk1, p1w0, p1w1, p1ka0, p1ka1, p1km0, p1km1, p1r0, p1r1; float p0v, p1v, m0, m1;
        SC_LD(p0, 0);
        SC_PART(p0);
#pragma unroll 2
        for (int t = 0; t < SC_T - 2; t += 2) {
            SC_LD(p1, t + 1);
            SC_STEP_M(p0, p1, t);
            SC_LD(p0, t + 2);
            SC_STEP_M(p1, p0, t + 1);
        }
        SC_LD(p1, SC_T - 1);
        SC_STEP_M(p0, p1, SC_T - 2);
        SC_STEP_L(p1, SC_T - 1);
        asm volatile("s_waitcnt lgkmcnt(0)" ::: "memory");
        if (lane < 32) { const int sy = lane >> 1, r4i = 8 * wave + 4 * (lane & 1);
            *(GAS f32x4*)(YR + (size_t)(b * SEQ + ck * SC_T + sy) * RW + h * 64 + half * 32 + r4i) = *(const LAS f32x4*)(lds + SC_YB + (ck & 1) * 2048 + sy * 128 + r4i * 4); }
        SC_WAIT();
        bcur = bnext;
    }
#undef SC_BAR
#undef SC_ARRIVE
#undef SC_WAIT
#undef SC_LOAD
#undef SC_UNP
#undef SC_STORE
#undef SC_LD
#undef SC_MUL
#undef SC_FMA
#undef SC_FNMA
#undef SC_RED1
#undef SC_RED2
#undef SC_RED2L
#undef SC_PART
#undef SC_BODY
#undef SC_UPD1
#undef SC_UPD2
#undef SC_STEP_M
#undef SC_STEP_L
    __builtin_amdgcn_s_setprio(0);
    }
    __syncthreads();
}

constexpr int FX_KP = 272, FX_VP = 320, FX_K0 = 0, FX_KB = 64 * FX_KP, FX_V0 = 2 * FX_KB, FX_VB = 64 * FX_VP, FX_C0 = FX_V0 + 2 * FX_VB, FX_CB = 256;
DI void fox_block(const bf16* PROJ, const float* Cb, bf16* MIX, int b, int h, int xq, LAS unsigned char* lds, int tid, int wave, int lane) {
    const int c = lane & 31, hh = lane >> 5, i16 = lane & 15, q4 = i16 >> 2, p4 = i16 & 3, blk = (lane >> 4) & 1;
    const int qbase = xq * 256 + 32 * wave, q_abs = qbase + c;
    const size_t rowq = (size_t)(b * SEQ + q_abs);
    bf16x8 qf[8];
#pragma unroll
    for (int ks = 0; ks < 8; ++ks) qf[ks] = *(const GAS bf16x8*)(PROJ + rowq * NIN + h * FOXD + 16 * ks + 8 * hh);
    const float cq2 = Cb[q_abs];
    f32x16 o[4];
#pragma unroll
    for (int d = 0; d < 4; ++d)
#pragma unroll
        for (int i = 0; i < 16; ++i) o[d][i] = 0.f;
    float mrun = -1e30f, lrun = 0.f;
    const int ntiles = 4 * (xq + 1);
    const int key0 = tid >> 4, c16 = tid & 15;
    const bf16* kg = PROJ + (size_t)(b * SEQ + key0) * NIN + 2048 + h * FOXD + 8 * c16;
    const int kl = key0 * FX_KP + c16 * 16, vl = key0 * FX_VP + c16 * 16;
    u32x4 kr0, kr1, vr0, vr1; float ckr = 0.f;
#define FX_LOAD(j) do { const bf16* _p = kg + (size_t)(j) * 64 * NIN; kr0 = *(const GAS u32x4*)_p; kr1 = *(const GAS u32x4*)(_p + (size_t)32 * NIN); vr0 = *(const GAS u32x4*)(_p + 2048); vr1 = *(const GAS u32x4*)(_p + (size_t)32 * NIN + 2048); \
        if (tid < 64) ckr = Cb[(j) * 64 + tid]; } while (0)
#define FX_STORE(bi) do { *(LAS u32x4*)(lds + FX_K0 + (bi) * FX_KB + kl) = kr0; *(LAS u32x4*)(lds + FX_K0 + (bi) * FX_KB + kl + 32 * FX_KP) = kr1; \
        *(LAS u32x4*)(lds + FX_V0 + (bi) * FX_VB + vl) = vr0; *(LAS u32x4*)(lds + FX_V0 + (bi) * FX_VB + vl + 32 * FX_VP) = vr1; if (tid < 64) *(LAS float*)(lds + FX_C0 + (bi) * FX_CB + tid * 4) = ckr; } while (0)
    FX_LOAD(0); FX_STORE(0);
    __syncthreads();
    const float C2S = 0.08838834764831845f * LOG2E;
    const int kbase = c * FX_KP + hh * 16, vbase = (4 * hh + q4) * FX_VP + blk * 32 + p4 * 8;
    for (int j = 0; j < ntiles; ++j) {
        const int bi = j & 1;
        if (j + 1 < ntiles) FX_LOAD(j + 1);
        if (64 * j <= qbase + 31) {
            const LAS unsigned char* KL = lds + FX_K0 + bi * FX_KB + kbase; const LAS unsigned char* VL = lds + FX_V0 + bi * FX_VB + vbase; const LAS unsigned char* CL = lds + FX_C0 + bi * FX_CB + hh * 16;
            f32x16 p0, p1;
#pragma unroll
            for (int i = 0; i < 16; ++i) { p0[i] = 0.f; p1[i] = 0.f; }
#pragma unroll
            for (int ks = 0; ks < 8; ++ks) { const bf16x8 a0 = *(const LAS bf16x8*)(KL + ks * 32), a1 = *(const LAS bf16x8*)(KL + 32 * FX_KP + ks * 32);
                p0 = __builtin_amdgcn_mfma_f32_32x32x16_bf16(a0, qf[ks], p0, 0, 0, 0); p1 = __builtin_amdgcn_mfma_f32_32x32x16_bf16(a1, qf[ks], p1, 0, 0, 0); }
#pragma unroll
            for (int gI = 0; gI < 4; ++gI) { const f32x4 c0 = *(const LAS f32x4*)(CL + gI * 32), c1 = *(const LAS f32x4*)(CL + 128 + gI * 32);
#pragma unroll
                for (int jj = 0; jj < 4; ++jj) { p0[4 * gI + jj] = fmaf(p0[4 * gI + jj], C2S, -c0[jj]); p1[4 * gI + jj] = fmaf(p1[4 * gI + jj], C2S, -c1[jj]); } }
            if (64 * j + 63 > qbase) {
                const float NEG = -__builtin_inff();
#pragma unroll
                for (int i = 0; i < 16; ++i) { const int key = 64 * j + (i & 3) + 8 * (i >> 2) + 4 * hh; if (key > q_abs) p0[i] = NEG; if (key + 32 > q_abs) p1[i] = NEG; }
            }
            float mt = fmaxf(p0[0], p1[0]);
#pragma unroll
            for (int i = 1; i < 16; ++i) mt = fmaxf(mt, fmaxf(p0[i], p1[i]));
            mt = fmaxf(mt, __shfl_xor(mt, 32));
            const float mn = fmaxf(mrun, mt), alpha = __builtin_amdgcn_exp2f(mrun - mn); mrun = mn;
            float ls = 0.f;
#pragma unroll
            for (int i = 0; i < 16; ++i) { p0[i] = __builtin_amdgcn_exp2f(p0[i] - mn); p1[i] = __builtin_amdgcn_exp2f(p1[i] - mn); ls += p0[i] + p1[i]; }
            lrun = lrun * alpha + ls;
#pragma unroll
            for (int d = 0; d < 4; ++d)
#pragma unroll
                for (int i = 0; i < 16; ++i) o[d][i] *= alpha;
            bf16x8 pf[2][2];
#pragma unroll
            for (int s = 0; s < 2; ++s) {
                u32x4 w0, w1; w0.x = pk2(p0[8 * s], p0[8 * s + 1]); w0.y = pk2(p0[8 * s + 2], p0[8 * s + 3]); w0.z = pk2(p0[8 * s + 4], p0[8 * s + 5]); w0.w = pk2(p0[8 * s + 6], p0[8 * s + 7]);
                w1.x = pk2(p1[8 * s], p1[8 * s + 1]); w1.y = pk2(p1[8 * s + 2], p1[8 * s + 3]); w1.z = pk2(p1[8 * s + 4], p1[8 * s + 5]); w1.w = pk2(p1[8 * s + 6], p1[8 * s + 7]);
                pf[0][s] = __builtin_bit_cast(bf16x8, w0); pf[1][s] = __builtin_bit_cast(bf16x8, w1); }
#pragma unroll
            for (int d = 0; d < 4; ++d)
#pragma unroll
                for (int kb = 0; kb < 2; ++kb)
#pragma unroll
                    for (int s = 0; s < 2; ++s) {
                        const s16x4 lo = __builtin_amdgcn_ds_read_tr16_b64_v4i16((LAS s16x4*)(VL + (32 * kb + 16 * s) * FX_VP + d * 64));
                        const s16x4 hi = __builtin_amdgcn_ds_read_tr16_b64_v4i16((LAS s16x4*)(VL + (32 * kb + 16 * s + 8) * FX_VP + d * 64));
                        const bf16x8 av = __builtin_shufflevector(lo, hi, 0, 1, 2, 3, 4, 5, 6, 7);
                        o[d] = __builtin_amdgcn_mfma_f32_32x32x16_bf16(av, pf[kb][s], o[d], 0, 0, 0); }
        }
        if (j + 1 < ntiles) FX_STORE(bi ^ 1);
        __syncthreads();
    }
#undef FX_LOAD
#undef FX_STORE
    const float ltot = lrun + __shfl_xor(lrun, 32); const float inv = 1.0f / ltot;
    bf16* orow = MIX + rowq * D + h * FOXD + 4 * hh;
#pragma unroll
    for (int d = 0; d < 4; ++d)
#pragma unroll
        for (int gI = 0; gI < 4; ++gI) { u32x2 w; w.x = pk2(o[d][4 * gI] * inv, o[d][4 * gI + 1] * inv); w.y = pk2(o[d][4 * gI + 2] * inv, o[d][4 * gI + 3] * inv);
            *(GAS u32x2*)(orow + 32 * d + 8 * gI) = w; }
}
DI void fox_phase(CArgs& a, LAS unsigned char* lds, int tid, int wave, int lane) {
    const bf16* PROJ = (const bf16*)(a.ws + WS_BIG); const float* C = (const float*)(a.ws + WS_C); bf16* MIX = (bf16*)(a.ws + WS_ACT2);
    for (int u = blockIdx.x; u < 256; u += gridDim.x) { const int bh = u >> 2, y = u & 3, b = bh >> 4, h = bh & 15;
        for (int s2 = 0; s2 < 2; ++s2) fox_block(PROJ, C + (size_t)bh * SEQ, MIX, b, h, s2 ? y : 7 - y, lds, tid, wave, lane); }
}

constexpr int F4_B = SC_CVT, F4_VP = 304, F4_K = F4_B, F4_V = F4_K + 64 * FX_KP, F4_C = F4_V + 64 * F4_VP, F4_Q = F4_C + 256, F4_QW = 32 * FX_KP;
static_assert(F4_Q + 4 * F4_QW <= MISC_OFF, "fox4 LDS map");
constexpr float FOX_THR = 16.0f;
DI void fox4_tile(const LAS unsigned char* KL, const LAS unsigned char* VL, const LAS unsigned char* CL, const LAS unsigned char* QL, int j, int qbase, int q_abs, int hh, float cq2, f32x16 (&o)[4], float& mrun, float& lrun) {
    const float C2S = 0.08838834764831845f * LOG2E;
    f32x16 p0, p1;
#pragma unroll
    for (int i = 0; i < 16; ++i) { p0[i] = 0.f; p1[i] = 0.f; }
#pragma unroll
    for (int ks = 0; ks < 8; ++ks) { const bf16x8 a0 = *(const LAS bf16x8*)(KL + ks * 32), a1 = *(const LAS bf16x8*)(KL + 32 * FX_KP + ks * 32), qk = *(const LAS bf16x8*)(QL + ks * 32);
        p0 = __builtin_amdgcn_mfma_f32_32x32x16_bf16(a0, qk, p0, 0, 0, 0); p1 = __builtin_amdgcn_mfma_f32_32x32x16_bf16(a1, qk, p1, 0, 0, 0); }
#pragma unroll
    for (int gI = 0; gI < 4; ++gI) { const f32x4 c0 = *(const LAS f32x4*)(CL + gI * 32), c1 = *(const LAS f32x4*)(CL + 128 + gI * 32);
#pragma unroll
        for (int jj = 0; jj < 4; ++jj) { p0[4 * gI + jj] = fmaf(p0[4 * gI + jj], C2S, -c0[jj]); p1[4 * gI + jj] = fmaf(p1[4 * gI + jj], C2S, -c1[jj]); } }
    if (64 * j + 63 > qbase) {
        const float NEG = -__builtin_inff();
#pragma unroll
        for (int i = 0; i < 16; ++i) { const int key = 64 * j + (i & 3) + 8 * (i >> 2) + 4 * hh; if (key > q_abs) p0[i] = NEG; if (key + 32 > q_abs) p1[i] = NEG; }
    }
    float mt = fmaxf(p0[0], p1[0]);
#pragma unroll
    for (int i = 1; i < 16; ++i) mt = fmaxf(mt, fmaxf(p0[i], p1[i]));
    mt = fmaxf(mt, __shfl_xor(mt, 32));
    const bool need = mt > mrun + FOX_THR;
    if (__builtin_amdgcn_ballot_w64(need)) {
        const float mn = need ? mt : mrun, alpha = __builtin_amdgcn_exp2f(mrun - mn); mrun = mn; lrun *= alpha;
#pragma unroll
        for (int d = 0; d < 4; ++d)
#pragma unroll
            for (int i = 0; i < 16; ++i) o[d][i] *= alpha;
    }
    const float mn = mrun;
    float ls = 0.f;
#pragma unroll
    for (int i = 0; i < 16; ++i) { p0[i] = __builtin_amdgcn_exp2f(p0[i] - mn); p1[i] = __builtin_amdgcn_exp2f(p1[i] - mn); ls += p0[i] + p1[i]; }
    lrun += ls;
    bf16x8 pf[2][2];
#pragma unroll
    for (int s = 0; s < 2; ++s) {
        u32x4 w0, w1; w0.x = pk2(p0[8 * s], p0[8 * s + 1]); w0.y = pk2(p0[8 * s + 2], p0[8 * s + 3]); w0.z = pk2(p0[8 * s + 4], p0[8 * s + 5]); w0.w = pk2(p0[8 * s + 6], p0[8 * s + 7]);
        w1.x = pk2(p1[8 * s], p1[8 * s + 1]); w1.y = pk2(p1[8 * s + 2], p1[8 * s + 3]); w1.z = pk2(p1[8 * s + 4], p1[8 * s + 5]); w1.w = pk2(p1[8 * s + 6], p1[8 * s + 7]);
        pf[0][s] = __builtin_bit_cast(bf16x8, w0); pf[1][s] = __builtin_bit_cast(bf16x8, w1); }
#pragma unroll
    for (int d = 0; d < 4; ++d)
#pragma unroll
        for (int kb = 0; kb < 2; ++kb)
#pragma unroll
            for (int s = 0; s < 2; ++s) {
                const s16x4 lo = __builtin_amdgcn_ds_read_tr16_b64_v4i16((LAS s16x4*)(VL + (32 * kb + 16 * s) * F4_VP + d * 64));
                const s16x4 hi = __builtin_amdgcn_ds_read_tr16_b64_v4i16((LAS s16x4*)(VL + (32 * kb + 16 * s + 8) * F4_VP + d * 64));
                const bf16x8 av = __builtin_shufflevector(lo, hi, 0, 1, 2, 3, 4, 5, 6, 7);
                o[d] = __builtin_amdgcn_mfma_f32_32x32x16_bf16(av, pf[kb][s], o[d], 0, 0, 0); }
}
DI void fox4_run(CArgs& a, int u, LAS unsigned char* lds, volatile LAS unsigned* cnt, unsigned& target, int w4, int lane) {
    const bf16* PROJ = (const bf16*)(a.ws + WS_BIG); bf16* MIX = (bf16*)(a.ws + WS_ACT2);
    const int bh = u >> 2, y = u & 3, b = bh >> 4, h = bh & 15; const float* Cb = (const float*)(a.ws + WS_C) + (size_t)bh * SEQ;
    const int t4 = w4 * 64 + lane;
#define F4_BAR() do { asm volatile("s_waitcnt lgkmcnt(0)" ::: "memory"); if (lane == 0) __hip_atomic_fetch_add((LAS unsigned*)cnt, 1u, __ATOMIC_RELAXED, __HIP_MEMORY_SCOPE_WORKGROUP); target += 4u; \
        while ((int)(__hip_atomic_load((LAS unsigned*)cnt, __ATOMIC_RELAXED, __HIP_MEMORY_SCOPE_WORKGROUP) - target) < 0) { } asm volatile("" ::: "memory"); } while (0)
    const int c = lane & 31, hh = lane >> 5, i16 = lane & 15, q4 = i16 >> 2, p4 = i16 & 3, blk = (lane >> 4) & 1;
    const int key0 = t4 >> 4, c16 = t4 & 15;
    const unsigned koff = (unsigned)(key0 * NIN + 8 * c16) * 2u;
    const int kl = key0 * FX_KP + c16 * 16, vl = key0 * F4_VP + c16 * 16;
    const int kbase = c * FX_KP + hh * 16, vbase = (4 * hh + q4) * F4_VP + blk * 32 + p4 * 8;
    LAS unsigned char* QLw = lds + F4_Q + w4 * F4_QW + c * FX_KP + hh * 16;
    F4_BAR();
#pragma unroll 1
    for (int bi = 0; bi < 4; ++bi) {
        const int xq = (bi == 0) ? 15 - y : (bi == 1) ? 8 + y : (bi == 2) ? 7 - y : y;
        const int qbase = xq * 128 + 32 * w4, q_abs = qbase + c; const size_t rowq = (size_t)(b * SEQ + q_abs);
#pragma unroll
        for (int ks = 0; ks < 8; ++ks) *(LAS bf16x8*)(QLw + ks * 32) = *(const GAS bf16x8*)(PROJ + rowq * NIN + h * FOXD + 16 * ks + 8 * hh);
        const float cq2 = Cb[q_abs];
        f32x16 o[4];
#pragma unroll
        for (int d = 0; d < 4; ++d)
#pragma unroll
            for (int i = 0; i < 16; ++i) o[d][i] = 0.f;
        float mrun = -1e30f, lrun = 0.f;
        const int ntiles = 2 * (xq + 1);
        u32x4 kr[4], vr[4]; float ckr = 0.f;
#define F4_LOAD(j) do { const char* _b = (const char*)PROJ + ((size_t)(b * SEQ + (j) * 64) * NIN + 2048 + h * FOXD) * 2; \
        _Pragma("unroll") for (int _i = 0; _i < 4; ++_i) { kr[_i] = *(const GAS u32x4*)(_b + (size_t)(16 * _i) * NIN * 2 + koff); vr[_i] = *(const GAS u32x4*)(_b + (size_t)(16 * _i) * NIN * 2 + 4096 + koff); } \
        if (t4 < 64) ckr = Cb[(j) * 64 + t4]; } while (0)
#define F4_STORE() do { _Pragma("unroll") for (int _i = 0; _i < 4; ++_i) { *(LAS u32x4*)(lds + F4_K + kl + 16 * _i * FX_KP) = kr[_i]; *(LAS u32x4*)(lds + F4_V + vl + 16 * _i * F4_VP) = vr[_i]; } \
        if (t4 < 64) *(LAS float*)(lds + F4_C + t4 * 4) = ckr; } while (0)
        F4_LOAD(0); F4_STORE();
        F4_BAR();
        for (int j = 0; j < ntiles; ++j) {
            if (j + 1 < ntiles) F4_LOAD(j + 1);
            if (64 * j <= qbase + 31) fox4_tile(lds + F4_K + kbase, lds + F4_V + vbase, lds + F4_C + hh * 16, QLw, j, qbase, q_abs, hh, cq2, o, mrun, lrun);
            F4_BAR();
            if (j + 1 < ntiles) F4_STORE();
            F4_BAR();
        }
#undef F4_LOAD
#undef F4_STORE
        const float ltot = lrun + __shfl_xor(lrun, 32); const float inv = 1.0f / ltot;
        bf16* orow = MIX + rowq * D + h * FOXD + 4 * hh;
#pragma unroll
        for (int d = 0; d < 4; ++d)
#pragma unroll
            for (int gI = 0; gI < 4; ++gI) { u32x2 w; w.x = pk2(o[d][4 * gI] * inv, o[d][4 * gI + 1] * inv); w.y = pk2(o[d][4 * gI + 2] * inv, o[d][4 * gI + 3] * inv);
                *(GAS u32x2*)(orow + 32 * d + 8 * gI) = w; }
    }
#undef F4_BAR
}

#ifndef MK_ONE_LAUNCH
#define MK_ONE_LAUNCH 1
#endif

constexpr int N_PHASES = 19;
#ifndef PROBE_REPS
#define PROBE_REPS {1,1,1,1,1, 1,1,1,1,1, 1,1,1,1,1, 1,1,1,1}
#endif
constexpr int REPS_[N_PHASES] = PROBE_REPS;
__global__ void __launch_bounds__(NTHR, 2) fwd(Args args_) {
    CArgs* argp_ = (CArgs*)__builtin_amdgcn_kernarg_segment_ptr(); asm volatile("" : "+s"(argp_)); CArgs& args = *argp_; (void)args_;
    extern __shared__ __attribute__((aligned(16))) unsigned char smem[];
    LAS unsigned char* lds = (LAS unsigned char*)smem;
    const int wave = __builtin_amdgcn_readfirstlane((int)threadIdx.x >> 6);
#define lane lane_id()
#define tid (wave * 64 + lane_id())
    const int G = gridDim.x, cid = blockIdx.x;
    volatile LAS unsigned* MISC = (volatile LAS unsigned*)(lds + MISC_OFF);
    for (int u = threadIdx.x; u < (LDS_BYTES - MISC_OFF) / 4; u += NTHR) MISC[u] = 0u;
    __syncthreads();
    const int lo = args.ph_lo, hi = args.ph_hi;
    unsigned* barw = (unsigned*)(args.ws + WS_CTL) + CW_BAR;
    XcdBarrier bar; bar.bar = barw; bar.x = 0; bar.st = MISC; bar.wave = wave;
    if (hi - lo > 1) bar = xcd_barrier_post(barw, MISC, wave);
#define IN(k) (lo <= (k) && (k) < hi)
#define SEAM(k) do { if (IN(k) && IN((k) + 1)) xcd_barrier(bar); } while (0)
    unsigned char* ws = args.ws;
    bf16* H = (bf16*)(ws + WS_H); bf16* U = (bf16*)(ws + WS_BIG); bf16* PROJ = (bf16*)(ws + WS_BIG); bf16* ACT2 = (bf16*)(ws + WS_ACT2);
    bf16* X = (bf16*)(ws + WS_X);
    bf16* Yb = (bf16*)(ws + WS_Y + 64 * MiB);
    const pg8::BatchOff Z0{0, 0, 1};

    if (IN(0)) { _Pragma("unroll") for (int rep_ = 0; rep_ < REPS_[0]; ++rep_) { if (rep_) xcd_barrier(bar); p0_prologue(args, lds, wave, lane); } SEAM(0); }
    if (IN(1)) { _Pragma("unroll") for (int rep_ = 0; rep_ < REPS_[1]; ++rep_) { if (rep_) xcd_barrier(bar);
        pg8::Gemm g{H, (const bf16*)(ws + WS_F1GU), D, D, D, Z0, Z0}; pg8::StaticOrder S; S.init(M, NGU, 1, G, cid);
        pg8::EpiSwiGLU E{U, FF, 1.0f};
        if (G == 256) {
            const int nall_full = S.nall; S.nall = 10 * 256;
            pg8::gemm_phase<pg8::EpiSwiGLU>(lds, g, S, E, wave);
            if (wave == 0 && lane == 0) MISC[24] = atomicAdd((unsigned*)(ws + WS_P1CTR), 1u);
            __syncthreads();
            const unsigned k11 = MISC[24];
            if (k11 < 192u) { pg8::StaticOrder S2 = S; S2.nall = nall_full; S2.G = nall_full; S2.c = 10 * 256 + (int)k11; pg8::gemm_phase<pg8::EpiSwiGLU>(lds, g, S2, E, wave); }
            else tail_cvt(args, lds, wave, lane, CVT_EARLY, CVT_TAIL, (int)k11 - 192, 64);
        } else pg8::gemm_phase<pg8::EpiSwiGLU>(lds, g, S, E, wave);
        } SEAM(1); }
    if (IN(2)) { _Pragma("unroll") for (int rep_ = 0; rep_ < REPS_[2]; ++rep_) { if (rep_) xcd_barrier(bar);
        pg8::Gemm g{U, (const bf16*)(ws + WS_F1D), FF, FF, FF, Z0, Z0}; pg8::StaticOrder S; S.init(M, D, 1, G, cid);
        pg8::EpiBf16 E{Yb, D, Z0, -1, nullptr}; pg8::gemm_phase<pg8::EpiBf16>(lds, g, S, E, wave); } SEAM(2); }
    if (IN(3)) { _Pragma("unroll") for (int rep_ = 0; rep_ < REPS_[3]; ++rep_) { if (rep_) xcd_barrier(bar); seam_phase<false, true, false>(args.in[I_X], Yb, X, H, args.in[I_F1POST], args.in[I_MIXPRE], 0.5f, wave, lane, (float*)(ws + WS_RSTD), (unsigned*)(ws + WS_P1CTR) + 64); } SEAM(3); }
    if (IN(4)) { _Pragma("unroll") for (int rep_ = 0; rep_ < REPS_[4]; ++rep_) { if (rep_) xcd_barrier(bar);
        { pg8::Gemm g{X, (const bf16*)(ws + WS_W_IN), D, D, D, Z0, Z0}; pg8::StaticOrder S; S.init(M, NIN, 1, G, cid);
          pg8::EpiBf16R E{PROJ, NIN, 49, (float*)(ws + WS_FL), (const float*)(ws + WS_RSTD)}; pg8::gemm_phase<pg8::EpiBf16R>(lds, g, S, E, wave); }
        { pg8::Gemm g{(const bf16*)(ws + WS_MEMN), (const bf16*)(ws + WS_WK), D, D, D, Z0, Z0}; pg8::StaticOrder S; S.init(MM, D, 1, G, (cid + G - 64 % G) % G);
          pg8::EpiBf16 E{(bf16*)(ws + WS_KMEM), D, Z0, -1, nullptr}; pg8::gemm_phase<pg8::EpiBf16>(lds, g, S, E, wave); }
        { pg8::Gemm g{(const bf16*)(ws + WS_WV), (const bf16*)(ws + WS_MEMN), D, D, D, Z0, Z0}; pg8::StaticOrder S; S.init(D, MM, 1, G, (cid + G - 128 % G) % G);
          pg8::EpiBf16 E{(bf16*)(ws + WS_VT), MM, Z0, -1, nullptr}; pg8::gemm_phase<pg8::EpiBf16>(lds, g, S, E, wave); }
        if (G == 256 && cid >= 192) tail_cvt(args, lds, wave, lane, CVT_EARLY + CVT_TAIL, CVT_TAIL, cid - 192, 64);
        } SEAM(4); }
    if (IN(5)) { _Pragma("unroll") for (int rep_ = 0; rep_ < REPS_[5]; ++rep_) { if (rep_) xcd_barrier(bar); fox_cumsum_phase(args, lds, wave, lane); lora_act_phase(args, wave, lane); } SEAM(5); }
    if (IN(6)) { _Pragma("unroll") for (int rep_ = 0; rep_ < REPS_[6]; ++rep_) { if (rep_) xcd_barrier(bar);
        { pg8::Gemm g{(const bf16*)(ws + WS_ALORA), (const bf16*)(ws + WS_LORAW), ALD, LORA_K, LORA_K, Z0, Z0}; pg8::StaticOrder S; S.init(M, RW, 1, G, cid);
          pg8::EpiLora<0> E{args.in[I_W0], (float*)(ws + WS_WDEC), nullptr}; pg8::gemm_phase<pg8::EpiLora<0>>(lds, g, S, E, wave); }
        { pg8::Gemm g{(const bf16*)(ws + WS_ALORA) + LORA_K, (const bf16*)(ws + WS_LORAW) + (size_t)RW * LORA_K, ALD, LORA_K, LORA_K, Z0, Z0}; pg8::StaticOrder S; S.init(M, RW, 1, G, cid);
          pg8::EpiLora<1> E{args.in[I_A0], (float*)(ws + WS_AA), nullptr}; pg8::gemm_phase<pg8::EpiLora<1>>(lds, g, S, E, wave); }
        { pg8::Gemm g{(const bf16*)(ws + WS_ALORA) + 2 * LORA_K, (const bf16*)(ws + WS_LORAW) + (size_t)2 * RW * LORA_K, ALD, LORA_K, LORA_K, Z0, Z0}; pg8::StaticOrder S; S.init(M, RW, 1, G, cid);
          pg8::EpiLora<2> E{nullptr, nullptr, (bf16*)(ws + WS_G)}; pg8::gemm_phase<pg8::EpiLora<2>>(lds, g, S, E, wave); }
        } SEAM(6); }
    if (IN(7)) { _Pragma("unroll") for (int rep_ = 0; rep_ < REPS_[7]; ++rep_) { if (rep_) xcd_barrier(bar); for (int u = cid; u < 256; u += G) scan_unit(args, u, u == cid, lds, MISC + 4, tid, wave, lane); } SEAM(7); }
    if (IN(8)) { _Pragma("unroll") for (int rep_ = 0; rep_ < REPS_[8]; ++rep_) { if (rep_) xcd_barrier(bar); rwkv_post_phase(args, wave, lane); } SEAM(8); }
    if (IN(9)) { _Pragma("unroll") for (int rep_ = 0; rep_ < REPS_[9]; ++rep_) { if (rep_) xcd_barrier(bar);
        pg8::Gemm g{ACT2, (const bf16*)(ws + WS_W_OUT), D, D, D, Z0, Z0}; pg8::StaticOrder S; S.init(M, D, 1, G, cid);
        pg8::EpiBf16 E{Yb, D, Z0, -1, nullptr}; pg8::gemm_phase<pg8::EpiBf16>(lds, g, S, E, wave); } SEAM(9); }
    if (IN(10)) { _Pragma("unroll") for (int rep_ = 0; rep_ < REPS_[10]; ++rep_) { if (rep_) xcd_barrier(bar); seam_phase<false, false, false>(X, Yb, X, H, args.in[I_MIXPOST], args.in[I_XPRE], 1.0f, wave, lane, (float*)(ws + WS_RSTD), (unsigned*)(ws + WS_P1CTR) + 80); } SEAM(10); }
    if (IN(11)) { _Pragma("unroll") for (int rep_ = 0; rep_ < REPS_[11]; ++rep_) { if (rep_) xcd_barrier(bar);
        pg8::Gemm g{X, (const bf16*)(ws + WS_WQ), D, D, D, Z0, Z0}; pg8::StaticOrder S; S.init(M, D, 1, G, cid);
        pg8::EpiBf16R E{ACT2, D, -1, nullptr, (const float*)(ws + WS_RSTD)}; pg8::gemm_phase<pg8::EpiBf16R>(lds, g, S, E, wave); } SEAM(11); }
    if (IN(12)) { _Pragma("unroll") for (int rep_ = 0; rep_ < REPS_[12]; ++rep_) { if (rep_) xcd_barrier(bar);
        pg8::Gemm g{ACT2, (const bf16*)(ws + WS_KMEM), D, D, 1024, pg8::BatchOff{(long)SEQ * D, 1024, 4}, pg8::BatchOff{(long)NMEM * D, 1024, 4}}; pg8::StaticOrder S; S.init(SEQ, NMEM, 16, G, cid);
        pg8::EpiSoftmax E{(bf16*)(ws + WS_BIG), 0.03125f * LOG2E}; pg8::gemm_phase<pg8::EpiSoftmax, false>(lds, g, S, E, wave); } SEAM(12); }
    if (IN(13)) { _Pragma("unroll") for (int rep_ = 0; rep_ < REPS_[13]; ++rep_) { if (rep_) xcd_barrier(bar);
        pg8::Gemm g{(const bf16*)(ws + WS_BIG), (const bf16*)(ws + WS_VT), NMEM, MM, NMEM, pg8::BatchOff{(long)SEQ * NMEM, 0, 1}, pg8::BatchOff{NMEM, (long)1024 * MM, 4}}; pg8::StaticOrder S; S.init(SEQ, 1024, 16, G, cid);
        pg8::EpiBf16 E{ACT2, D, pg8::BatchOff{(long)SEQ * D, 1024, 4}, -1, nullptr}; pg8::gemm_phase<pg8::EpiBf16>(lds, g, S, E, wave); } SEAM(13); }
    if (IN(14)) { _Pragma("unroll") for (int rep_ = 0; rep_ < REPS_[14]; ++rep_) { if (rep_) xcd_barrier(bar);
        pg8::Gemm g{ACT2, (const bf16*)(ws + WS_WO), D, D, D, Z0, Z0}; pg8::StaticOrder S; S.init(M, D, 1, G, cid);
        pg8::EpiBf16 E{Yb, D, Z0, -1, nullptr}; pg8::gemm_phase<pg8::EpiBf16>(lds, g, S, E, wave); } SEAM(14); }
    if (IN(15)) { _Pragma("unroll") for (int rep_ = 0; rep_ < REPS_[15]; ++rep_) { if (rep_) xcd_barrier(bar); seam_phase<true, false, false>(X, Yb, X, H, args.in[I_XPOST], args.in[I_F2PRE], 1.0f, wave, lane, nullptr, (unsigned*)(ws + WS_P1CTR) + 96); } SEAM(15); }
    if (IN(16)) { _Pragma("unroll") for (int rep_ = 0; rep_ < REPS_[16]; ++rep_) { if (rep_) xcd_barrier(bar);
        pg8::Gemm g{H, (const bf16*)(ws + WS_F2GU), D / 2, D / 2, D / 2, Z0, Z0}; pg8::StaticOrder S; S.init(M, NGU, 1, G, cid);
        pg8::EpiSwiGLU8 E{(unsigned char*)U, FF, 1.0f / 512.0f};
        if (G == 256) {
            const int nall_full = S.nall; S.nall = 10 * 256;
            pg8::gemm_phase<pg8::EpiSwiGLU8, true, true, true>(lds, g, S, E, wave);
            if (wave == 0 && lane == 0) MISC[25] = atomicAdd((unsigned*)(ws + WS_P1CTR) + 16, 1u);
            __syncthreads();
            const unsigned k11 = MISC[25];
            if (k11 < 192u) { pg8::StaticOrder S2 = S; S2.nall = nall_full; S2.G = nall_full; S2.c = 10 * 256 + (int)k11; pg8::gemm_phase<pg8::EpiSwiGLU8, true, true, true>(lds, g, S2, E, wave); }
        } else pg8::gemm_phase<pg8::EpiSwiGLU8, true, true, true>(lds, g, S, E, wave);
        } SEAM(16); }
    if (IN(17)) { _Pragma("unroll") for (int rep_ = 0; rep_ < REPS_[17]; ++rep_) { if (rep_) xcd_barrier(bar);
        pg8::Gemm g{U, (const bf16*)(ws + WS_F2D), FF / 2, FF / 2, FF / 2, Z0, Z0}; pg8::StaticOrder S; S.init(M, D, 1, G, cid);
        pg8::EpiBf16S E{Yb, D, 1.0f / 1024.0f}; pg8::gemm_phase<pg8::EpiBf16S, true, true, true>(lds, g, S, E, wave); } SEAM(17); }
    if (IN(18)) { _Pragma("unroll") for (int rep_ = 0; rep_ < REPS_[18]; ++rep_) { if (rep_) xcd_barrier(bar); seam_phase<false, false, true>(X, Yb, args.out, nullptr, args.in[I_F2POST], nullptr, 0.5f, wave, lane, nullptr, (unsigned*)(ws + WS_P1CTR) + 112); } }
#undef IN
#undef SEAM
#undef lane
#undef tid
}

extern "C" void kernel_launch(void* const* d_in, const int* in_sizes, int n_in, void* d_out, int out_size, void* d_ws, size_t ws_size, hipStream_t stream) {
    static int grid = 0;
    if (grid == 0) {
        if (n_in != 35 || in_sizes[0] != M * D || out_size != M * D || ws_size < WS_END) { fprintf(stderr, "kernel_launch: unexpected shapes (n_in %d, in0 %d, out %d, ws %zu < %zu)\n", n_in, n_in > 0 ? in_sizes[0] : -1, out_size, ws_size, (size_t)WS_END); grid = -1; return; }
        int dev = 0, cus = 0;
        if (hipGetDevice(&dev) != hipSuccess || hipDeviceGetAttribute(&cus, hipDeviceAttributeMultiprocessorCount, dev) != hipSuccess) { grid = -1; return; }
        if (hipFuncSetAttribute((const void*)fwd, hipFuncAttributeMaxDynamicSharedMemorySize, LDS_BYTES) != hipSuccess) { fprintf(stderr, "kernel_launch: hipFuncSetAttribute failed\n"); grid = -1; return; }
        int per_cu = 0;
        if (hipOccupancyMaxActiveBlocksPerMultiprocessor(&per_cu, (const void*)fwd, NTHR, LDS_BYTES) != hipSuccess || per_cu < 1) { fprintf(stderr, "kernel_launch: occupancy query says %d\n", per_cu); (void)hipGetLastError(); }
        grid = cus;
    }
    if (grid < 0) return;
    (void)hipMemsetAsync((char*)d_ws + WS_CTL, 0, CTL_ZERO_BYTES, stream);
    Args a{};
    for (int i = 0; i < 35; ++i) a.in[i] = (const float*)d_in[i];
    a.out = (float*)d_out; a.ws = (unsigned char*)d_ws;
#if MK_ONE_LAUNCH
    a.ph_lo = 0; a.ph_hi = N_PHASES;
    hipLaunchKernelGGL(fwd, dim3(grid), dim3(NTHR), LDS_BYTES, stream, a);
#else
    for (int p = MK_PH_BEG; p < MK_PH_END; ++p) { a.ph_lo = p; a.ph_hi = p + 1; hipLaunchKernelGGL(fwd, dim3(grid), dim3(NTHR), LDS_BYTES, stream, a); }
#endif
}
```

```cpp
#include <hip/hip_runtime.h>
#include <cstdio>
#include <cstdint>

#ifndef FOX_PRIO
#define FOX_PRIO 0
#endif
#define MK_PH_BEG 0
#define MK_PH_END 19
#define P0_PARTS 7
#define CVT_LO 0
#define CVT_HI CVT_EARLY
#define GAS __attribute__((address_space(1)))
#define LAS __attribute__((address_space(3)))
#define DI __device__ __forceinline__
typedef unsigned short bf16;
typedef short bf16x8 __attribute__((ext_vector_type(8)));
typedef short s16x4 __attribute__((ext_vector_type(4)));
typedef float f32x2 __attribute__((ext_vector_type(2)));
typedef float f32x4 __attribute__((ext_vector_type(4)));
typedef float f32x16 __attribute__((ext_vector_type(16)));
typedef unsigned u32x2 __attribute__((ext_vector_type(2)));
typedef unsigned u32x4 __attribute__((ext_vector_type(4)));
typedef __bf16 bf16x2_t __attribute__((ext_vector_type(2)));

DI int lane_id() { int l; asm volatile("v_mbcnt_lo_u32_b32 %0, -1, 0\n\tv_mbcnt_hi_u32_b32 %0, -1, %0" : "=v"(l)); return l; }
DI unsigned pk2(float lo, float hi) { f32x2 f = {lo, hi}; return __builtin_bit_cast(unsigned, __builtin_convertvector(f, bf16x2_t)); }
DI float bflo(unsigned u) { return __uint_as_float(u << 16); }
DI float bfhi(unsigned u) { return __uint_as_float(u & 0xffff0000u); }
DI float bf2f(bf16 b) { return __uint_as_float((unsigned)b << 16); }

constexpr int BATCH = 4, SEQ = 2048, M = BATCH * SEQ, D = 4096, FF = 11008, NGU = 2 * FF;
constexpr int NMEM = 256, MM = BATCH * NMEM;
constexpr int FOXH = 16, FOXD = 128, RH = 32, RD = 64, RW = 2048;
constexpr int IN_COLS = 12752, NIN = 12800;
constexpr int PC_RKV = 6144, PC_LORA = 12288, PC_FL = 12736;
constexpr int LORA_K = 256, ALD = 3 * LORA_K;
constexpr float RMS_EPS = 1e-6f, GN_EPS = 64e-5f, LOG2E = 1.4426950408889634f;

constexpr size_t MiB = 1u << 20;
constexpr size_t WS_CTL = 0, CTL_ZERO_BYTES = 1 * MiB;
constexpr size_t WS_P1CTR = WS_CTL + 900 * 1024;
constexpr size_t WS_RSTD = WS_CTL + 512 * 1024;
constexpr size_t WS_C = 1 * MiB;
constexpr size_t WS_FL = WS_C + 512 * 1024;
constexpr size_t WS_BON = 2 * MiB;
constexpr size_t WS_LORAW = 3 * MiB;
constexpr size_t WS_MEMN = 8 * MiB;
constexpr size_t WS_KMEM = 16 * MiB;
constexpr size_t WS_VT = 24 * MiB;
constexpr size_t WS_W_IN = 32 * MiB;
constexpr size_t WS_W_OUT = 132 * MiB, WS_WQ = 164 * MiB, WS_WO = 196 * MiB, WS_WK = 228 * MiB, WS_WV = 260 * MiB;
constexpr size_t WS_F1GU = 292 * MiB, WS_F1D = 464 * MiB, WS_F2GU = 550 * MiB, WS_F2D = 722 * MiB;
constexpr size_t WS_X = 808 * MiB;
constexpr size_t WS_Y = 936 * MiB;
constexpr size_t WS_WDEC = WS_Y, WS_AA = WS_Y + 64 * MiB;
constexpr size_t WS_H = 1064 * MiB;
constexpr size_t WS_YR = WS_H;
constexpr size_t WS_ACT2 = 1128 * MiB;
constexpr size_t WS_BIG = 1192 * MiB;
constexpr size_t WS_RR = 1392 * MiB, WS_RKM = 1424 * MiB, WS_RV = 1456 * MiB, WS_RKK = 1488 * MiB, WS_RKKA = 1520 * MiB;
constexpr size_t WS_G = 1552 * MiB;
constexpr size_t WS_ALORA = 1584 * MiB;
constexpr size_t WS_END = 1596 * MiB;

namespace pg8 {
typedef unsigned short bf16_t;
constexpr int BM = 256, BK = 64, HALF = 128, HTB = HALF * BK * 2, STAGE_BYTES = 8 * HTB, NXCD = 8, WGM = 8;
__host__ __device__ __forceinline__ int lds_byte(int r, int c) { const int st = (r >> 4) * 2 + (c >> 5), rr = r & 15, cc = c & 31, ob = rr * 64 + cc * 2; return st * 1024 + (ob ^ (((ob >> 9) & 1) << 5)); }
__host__ __device__ __forceinline__ void stage_rc(int b, int& R, int& C) { const int st = b / 1024, sb = b % 1024, swz = sb ^ (((sb >> 9) & 1) << 5); R = (st >> 1) * 16 + swz / 64; C = (st & 1) * 32 + (swz % 64) / 2; }
__host__ __device__ __forceinline__ int perm32(int rho) { const int n = rho >> 4, i = rho & 15; return 8 * (i >> 2) + 4 * n + (i & 3); }

struct Unit { int pm, pn, z; };
struct BatchOff { long hi, lo; int div; DI long off(int z) const { return (long)(z / div) * hi + (long)(z % div) * lo; } };
struct Gemm { const bf16_t* A; const bf16_t* Bt; int lda, ldb, K; BatchOff za, zb; };

struct StaticOrder {
    int nM, nN, nwg, nall, G, c;
    DI void init(int Mr, int Nc, int nz, int G_, int c_) { nM = Mr / BM; nN = Nc / BM; nwg = nM * nN; nall = nwg * nz; G = G_; c = c_; }
    DI bool next(int i, Unit& u) const {
        const long L = (long)i * G + c; if (L >= nall) return false;
        const int z = (int)(L / nwg); int wgid = (int)(L - (long)z * nwg);
        { const int q = nwg / NXCD, r = nwg % NXCD, xcd = wgid % NXCD, off = wgid / NXCD; wgid = (xcd < r ? xcd * (q + 1) : r * (q + 1) + (xcd - r) * q) + off; }
        const int nig = WGM * nN, gid = wgid / nig, fm = gid * WGM, gsz = (nM - fm) < WGM ? (nM - fm) : WGM;
        u.pm = fm + ((wgid % nig) % gsz); u.pn = (wgid % nig) / gsz; u.z = z; return true;
    }
};

typedef int i32x4 __attribute__((ext_vector_type(4)));
typedef int i32x8 __attribute__((ext_vector_type(8)));
template <class Epi, bool ALIGN_EPI = true, bool SP2 = true, bool F8 = false>
DI void gemm_phase(LAS unsigned char* lds, const Gemm g, const StaticOrder& S, const Epi& E, const int wid) {
    const int lane = lane_id(), tid = wid * 64 + lane, wr = wid >> 2, wc = wid & 3, fr = lane & 15, fq = lane >> 4;
    const int K = g.K, nt = K / BK;
    unsigned voff_A, voff_B;
    { int R, C; stage_rc(tid * 16, R, C); const int Rb = Epi::PERM ? ((R & ~31) + perm32(R & 31)) : R; voff_A = (unsigned)(R * g.lda + C) * 2u; voff_B = (unsigned)(Rb * g.ldb + C) * 2u; }
    const size_t r64A = (size_t)64 * g.lda * 2, r64B = (size_t)64 * g.ldb * 2;
    const size_t kstep = (size_t)(BK * 2);
    const size_t hstepA = (size_t)HALF * g.lda * 2, hstepB = (size_t)HALF * g.ldb * 2;
    const size_t tstepA = 2 * hstepA, tstepB = 2 * hstepB;
    const unsigned ldsw = (unsigned)wid * 1024u;
    const int aoff = lds_byte(wr * 64 + fr, fq * 8), boff = lds_byte(wc * 32 + fr, fq * 8);
#define PG8_SA(b, h) (((b) * 2 + (h)) * HTB)
#define PG8_SB(b, h) ((4 + (b) * 2 + (h)) * HTB)
#define PG8_STAGE(bufoff, gbase, voff) do { _Pragma("unroll") for (int _i = 0; _i < 2; ++_i) \
        __builtin_amdgcn_global_load_lds((const unsigned*)((const char*)(gbase) + (size_t)_i * r64##voff + voff_##voff), (LAS unsigned*)(lds + (bufoff) + ldsw + _i * 8192), 16, 0, 0); } while (0)
#define PG8_LDA(dst, b, h) do { _Pragma("unroll") for (int m = 0; m < 4; ++m) { if constexpr (F8) { const i32x4 _l = *(const LAS i32x4*)(lds + PG8_SA(b, h) + aoff + m * 2048), _h = *(const LAS i32x4*)(lds + PG8_SA(b, h) + aoff + m * 2048 + 1024); dst##8[m] = __builtin_shufflevector(_l, _h, 0, 1, 2, 3, 4, 5, 6, 7); } \
        else { _Pragma("unroll") for (int k = 0; k < 2; ++k) dst[m][k] = *(const LAS bf16x8*)(lds + PG8_SA(b, h) + aoff + m * 2048 + k * 1024); } } } while (0)
#define PG8_LDB(dst, b, h) do { _Pragma("unroll") for (int n = 0; n < 2; ++n) { if constexpr (F8) { const i32x4 _l = *(const LAS i32x4*)(lds + PG8_SB(b, h) + boff + n * 2048), _h = *(const LAS i32x4*)(lds + PG8_SB(b, h) + boff + n * 2048 + 1024); dst##8[n] = __builtin_shufflevector(_l, _h, 0, 1, 2, 3, 4, 5, 6, 7); } \
        else { _Pragma("unroll") for (int k = 0; k < 2; ++k) dst[n][k] = *(const LAS bf16x8*)(lds + PG8_SB(b, h) + boff + n * 2048 + k * 1024); } } } while (0)
#define PG8_MMA(ai, bj, At, Bt) do { __builtin_amdgcn_s_setprio(1); _Pragma("unroll") for (int m = 0; m < 4; ++m) _Pragma("unroll") for (int n = 0; n < 2; ++n) { \
        if constexpr (F8) acc[ai][bj][m][n] = __builtin_amdgcn_mfma_scale_f32_16x16x128_f8f6f4(Bt##8[n], At##8[m], acc[ai][bj][m][n], 0, 0, 0, 0, 0, 0);     \
        else { _Pragma("unroll") for (int k = 0; k < 2; ++k) acc[ai][bj][m][n] = __builtin_amdgcn_mfma_f32_16x16x32_bf16(Bt[n][k], At[m][k], acc[ai][bj][m][n], 0, 0, 0); } } \
        __builtin_amdgcn_s_setprio(0); } while (0)
#define PG8_WAIT_V(n) asm volatile("s_waitcnt vmcnt(" #n ")" ::: "memory")
#define PG8_WAIT_L(n) asm volatile("s_waitcnt lgkmcnt(" #n ")" ::: "memory")
#define PG8_BAR __builtin_amdgcn_s_barrier()
#define PG8_SCHED __builtin_amdgcn_sched_barrier(0)
    Unit cur, nxt; int ui = 0;
    if (!S.next(0, cur)) return;
    f32x4 acc[2][2][4][2];
#pragma unroll
    for (int a = 0; a < 2; ++a)
#pragma unroll
        for (int b = 0; b < 2; ++b)
#pragma unroll
            for (int m = 0; m < 4; ++m)
#pragma unroll
                for (int n = 0; n < 2; ++n) acc[a][b][m][n] = (f32x4){0.f, 0.f, 0.f, 0.f};
    bf16x8 At[4][2], B0[2][2], B1[2][2]; i32x8 At8[4], B08[2], B18[2];
    const char* cA = (const char*)(g.A + g.za.off(cur.z)) + (size_t)cur.pm * tstepA; const char* cB = (const char*)(g.Bt + g.zb.off(cur.z)) + (size_t)cur.pn * tstepB;
    if constexpr (SP2) {
        PG8_STAGE(PG8_SB(0, 0), cB, B); PG8_STAGE(PG8_SB(0, 1), cB + hstepB, B); PG8_STAGE(PG8_SA(0, 0), cA, A); PG8_STAGE(PG8_SA(0, 1), cA + hstepA, A);
        if (wr == 1) PG8_BAR;
        PG8_WAIT_V(2); PG8_BAR;
        PG8_STAGE(PG8_SB(1, 0), cB + kstep, B); PG8_STAGE(PG8_SA(1, 0), cA + kstep, A); PG8_STAGE(PG8_SB(1, 1), cB + hstepB + kstep, B);
        PG8_WAIT_V(6); PG8_BAR;
    } else {
        PG8_STAGE(PG8_SB(0, 0), cB, B); PG8_STAGE(PG8_SA(0, 0), cA, A); PG8_STAGE(PG8_SB(0, 1), cB + hstepB, B); PG8_STAGE(PG8_SA(0, 1), cA + hstepA, A);
        if (wr == 1) PG8_BAR;
        PG8_WAIT_V(4); PG8_BAR;
        PG8_STAGE(PG8_SB(1, 0), cB + kstep, B); PG8_STAGE(PG8_SA(1, 0), cA + kstep, A); PG8_STAGE(PG8_SB(1, 1), cB + hstepB + kstep, B);
        PG8_WAIT_V(6); PG8_BAR;
    }
    for (;;) {
        const bool has_next = S.next(ui + 1, nxt);
        const char* nA = has_next ? (const char*)(g.A + g.za.off(nxt.z)) + (size_t)nxt.pm * tstepA : cA; const char* nB = has_next ? (const char*)(g.Bt + g.zb.off(nxt.z)) + (size_t)nxt.pn * tstepB : cB;
        for (int t = 0; t < nt; t += 2) {
            const bool last = (t == nt - 2);
            const char* a1 = cA + (size_t)(t + 1) * kstep;
            const char* a2 = last ? nA : cA + (size_t)(t + 2) * kstep; const char* b2 = last ? nB : cB + (size_t)(t + 2) * kstep;
            const char* a3 = a2 + kstep; const char* b3 = b2 + kstep;
            if constexpr (SP2) {
            PG8_LDB(B0, 0, 0); PG8_LDB(B1, 0, 1); PG8_SCHED; PG8_LDA(At, 0, 0); PG8_STAGE(PG8_SA(1, 1), a1 + hstepA, A);
            PG8_WAIT_V(8); PG8_WAIT_L(0); PG8_BAR; PG8_MMA(0, 0, At, B0); PG8_MMA(0, 1, At, B1); PG8_BAR; PG8_SCHED;
            PG8_LDA(At, 0, 1); PG8_STAGE(PG8_SB(0, 0), b2, B); PG8_STAGE(PG8_SB(0, 1), b2 + hstepB, B); PG8_STAGE(PG8_SA(0, 0), a2, A);
            PG8_WAIT_V(8); PG8_WAIT_L(0); PG8_BAR; PG8_MMA(1, 0, At, B0); PG8_MMA(1, 1, At, B1); PG8_BAR; PG8_SCHED;
            PG8_LDB(B0, 1, 0); PG8_LDB(B1, 1, 1); PG8_SCHED; PG8_LDA(At, 1, 0); PG8_STAGE(PG8_SA(0, 1), a2 + hstepA, A);
            PG8_WAIT_V(8); PG8_WAIT_L(0); PG8_BAR; PG8_MMA(0, 0, At, B0); PG8_MMA(0, 1, At, B1); PG8_BAR; PG8_SCHED;
            PG8_LDA(At, 1, 1); PG8_STAGE(PG8_SB(1, 0), b3, B); PG8_STAGE(PG8_SB(1, 1), b3 + hstepB, B); PG8_STAGE(PG8_SA(1, 0), a3, A);
            PG8_WAIT_V(8); PG8_WAIT_L(0); PG8_BAR; PG8_MMA(1, 0, At, B0); PG8_MMA(1, 1, At, B1); PG8_BAR; PG8_SCHED;
            } else {
            PG8_LDB(B0, 0, 0); PG8_SCHED; PG8_LDA(At, 0, 0); PG8_STAGE(PG8_SA(1, 1), a1 + hstepA, A);
            PG8_WAIT_L(8); PG8_BAR; PG8_WAIT_L(0); PG8_MMA(0, 0, At, B0); PG8_BAR; PG8_SCHED;
            PG8_LDB(B1, 0, 1); PG8_STAGE(PG8_SB(0, 0), b2, B);
            PG8_BAR; PG8_WAIT_L(0); PG8_MMA(0, 1, At, B1); PG8_BAR;
            PG8_LDA(At, 0, 1); PG8_STAGE(PG8_SA(0, 0), a2, A);
            PG8_BAR; PG8_WAIT_L(0); PG8_MMA(1, 0, At, B0); PG8_BAR; PG8_SCHED;
            PG8_STAGE(PG8_SB(0, 1), b2 + hstepB, B);
            PG8_WAIT_V(6); PG8_BAR; PG8_MMA(1, 1, At, B1); PG8_BAR;
            PG8_LDB(B0, 1, 0); PG8_SCHED; PG8_LDA(At, 1, 0); PG8_STAGE(PG8_SA(0, 1), a2 + hstepA, A);
            PG8_WAIT_L(8); PG8_BAR; PG8_WAIT_L(0); PG8_MMA(0, 0, At, B0); PG8_BAR; PG8_SCHED;
            PG8_LDB(B1, 1, 1); PG8_STAGE(PG8_SB(1, 0), b3, B);
            PG8_BAR; PG8_WAIT_L(0); PG8_MMA(0, 1, At, B1); PG8_BAR;
            PG8_LDA(At, 1, 1); PG8_STAGE(PG8_SA(1, 0), a3, A);
            PG8_BAR; PG8_WAIT_L(0); PG8_MMA(1, 0, At, B0); PG8_BAR; PG8_SCHED;
            PG8_STAGE(PG8_SB(1, 1), b3 + hstepB, B);
            PG8_WAIT_V(6); PG8_BAR; PG8_MMA(1, 1, At, B1); PG8_BAR;
            }
        }
        if constexpr (ALIGN_EPI) { if (wr == 0) PG8_BAR; }
        if constexpr (!Epi::AFTER_DRAIN) {
            const int lz = lane_id(); E(acc, cur, wr, wc, lz & 15, lz >> 4); }
        if (!has_next) break;
#pragma unroll
        for (int a = 0; a < 2; ++a)
#pragma unroll
            for (int b = 0; b < 2; ++b)
#pragma unroll
                for (int m = 0; m < 4; ++m)
#pragma unroll
                    for (int n = 0; n < 2; ++n) acc[a][b][m][n] = (f32x4){0.f, 0.f, 0.f, 0.f};
        cur = nxt; cA = nA; cB = nB; ++ui;
        if constexpr (ALIGN_EPI) { if (wr == 1) PG8_BAR; }
    }
    PG8_WAIT_V(0);
    if constexpr (!ALIGN_EPI) { if (wr == 0) PG8_BAR; }
    PG8_BAR;
    if constexpr (Epi::AFTER_DRAIN) { const int lz = lane_id(); E.fused(acc, cur, wr, wc, lz & 15, lz >> 4, lds, wid, lz); }
#undef PG8_SA
#undef PG8_SB
#undef PG8_STAGE
#undef PG8_LDA
#undef PG8_LDB
#undef PG8_MMA
#undef PG8_WAIT_V
#undef PG8_WAIT_L
#undef PG8_BAR
#undef PG8_SCHED
}

struct EpiF32 {
    static constexpr bool PERM = false, AFTER_DRAIN = false;
    float* C; int ldc;
    DI void operator()(const f32x4 (&acc)[2][2][4][2], const Unit& u, int wr, int wc, int fr, int fq) const {
        const int row0 = u.pm * BM + wr * 64 + fr, col0 = u.pn * BM + wc * 32 + 4 * fq;
#pragma unroll
        for (int ai = 0; ai < 2; ++ai)
#pragma unroll
            for (int m = 0; m < 4; ++m) { float* rowp = C + (size_t)(row0 + ai * HALF + m * 16) * ldc + col0;
#pragma unroll
                for (int bj = 0; bj < 2; ++bj)
#pragma unroll
                    for (int n = 0; n < 2; ++n) *(f32x4*)(rowp + bj * HALF + n * 16) = acc[ai][bj][m][n]; }
    }
};
struct EpiBf16 {
    static constexpr bool PERM = true, AFTER_DRAIN = false;
    bf16_t* O; int ldc; BatchOff zo; int fl_tile; float* FL;
    DI void operator()(const f32x4 (&acc)[2][2][4][2], const Unit& u, int wr, int wc, int fr, int fq) const {
        const int row0 = u.pm * BM + wr * 64 + fr, col0 = u.pn * BM + wc * 32 + 8 * fq;
        bf16_t* base = O + zo.off(u.z);
#pragma unroll
        for (int ai = 0; ai < 2; ++ai)
#pragma unroll
            for (int m = 0; m < 4; ++m) { bf16_t* rowp = base + (size_t)(row0 + ai * HALF + m * 16) * ldc + col0;
#pragma unroll
                for (int bj = 0; bj < 2; ++bj) { const f32x4 v0 = acc[ai][bj][m][0], v1 = acc[ai][bj][m][1];
                    u32x4 w; w.x = pk2(v0[0], v0[1]); w.y = pk2(v0[2], v0[3]); w.z = pk2(v1[0], v1[1]); w.w = pk2(v1[2], v1[3]);
                    *(u32x4*)(rowp + bj * HALF) = w; } }
        if (u.pn == fl_tile && wc == 2 && fq < 2) {
#pragma unroll
            for (int ai = 0; ai < 2; ++ai)
#pragma unroll
                for (int m = 0; m < 4; ++m) { float* p = FL + (size_t)(row0 + ai * HALF + m * 16) * 16 + 8 * fq;
                    *(f32x4*)p = acc[ai][1][m][0]; *(f32x4*)(p + 4) = acc[ai][1][m][1]; }
        }
    }
};
struct EpiBf16R {
    static constexpr bool PERM = true, AFTER_DRAIN = false;
    bf16_t* O; int ldc; int fl_tile; float* FL; const float* rs;
    DI void operator()(const f32x4 (&acc)[2][2][4][2], const Unit& u, int wr, int wc, int fr, int fq) const {
        const int row0 = u.pm * BM + wr * 64 + fr, col0 = u.pn * BM + wc * 32 + 8 * fq;
#pragma unroll
        for (int ai = 0; ai < 2; ++ai)
#pragma unroll
            for (int m = 0; m < 4; ++m) { const int row = row0 + ai * HALF + m * 16; const float r = rs[row]; bf16_t* rowp = O + (size_t)row * ldc + col0;
#pragma unroll
                for (int bj = 0; bj < 2; ++bj) { const f32x4 v0 = acc[ai][bj][m][0] * r, v1 = acc[ai][bj][m][1] * r;
                    u32x4 w; w.x = pk2(v0[0], v0[1]); w.y = pk2(v0[2], v0[3]); w.z = pk2(v1[0], v1[1]); w.w = pk2(v1[2], v1[3]);
                    *(u32x4*)(rowp + bj * HALF) = w; }
                if (u.pn == fl_tile && wc == 2 && fq < 2) { float* p = FL + (size_t)row * 16 + 8 * fq; *(f32x4*)p = acc[ai][1][m][0] * r; *(f32x4*)(p + 4) = acc[ai][1][m][1] * r; } }
    }
};
struct EpiSwiGLU {
    static constexpr bool PERM = true, AFTER_DRAIN = false;
    bf16_t* O; int ldc; float sc;
    DI void operator()(const f32x4 (&acc)[2][2][4][2], const Unit& u, int wr, int wc, int fr, int fq) const {
        const int row0 = u.pm * BM + wr * 64 + fr, col0 = u.pn * HALF + wc * 32 + 8 * fq;
#pragma unroll
        for (int ai = 0; ai < 2; ++ai)
#pragma unroll
            for (int m = 0; m < 4; ++m) { float h[8];
#pragma unroll
                for (int n = 0; n < 2; ++n)
#pragma unroll
                    for (int j = 0; j < 4; ++j) { const float gt = acc[ai][0][m][n][j] * sc, up = acc[ai][1][m][n][j] * sc;
                        h[4 * n + j] = gt * __builtin_amdgcn_rcpf(1.0f + __builtin_amdgcn_exp2f(-gt * LOG2E)) * up; }
                u32x4 w; w.x = pk2(h[0], h[1]); w.y = pk2(h[2], h[3]); w.z = pk2(h[4], h[5]); w.w = pk2(h[6], h[7]);
                *(u32x4*)(O + (size_t)(row0 + ai * HALF + m * 16) * ldc + col0) = w; }
    }
};
struct EpiSwiGLU8 {
    static constexpr bool PERM = false, AFTER_DRAIN = false;
    unsigned char* O; int ldc; float sc;
    DI void operator()(const f32x4 (&acc)[2][2][4][2], const Unit& u, int wr, int wc, int fr, int fq) const {
        const int row0 = u.pm * BM + wr * 64 + fr, col0 = u.pn * HALF + wc * 32 + 4 * fq;
#pragma unroll
        for (int ai = 0; ai < 2; ++ai)
#pragma unroll
            for (int m = 0; m < 4; ++m)
#pragma unroll
                for (int n = 0; n < 2; ++n) { float h[4];
#pragma unroll
                    for (int j = 0; j < 4; ++j) { const float gt = acc[ai][0][m][n][j] * sc, up = acc[ai][1][m][n][j] * sc;
                        h[j] = __builtin_amdgcn_fmed3f(gt * __builtin_amdgcn_rcpf(1.0f + __builtin_amdgcn_exp2f(-gt * LOG2E)) * up * 16.0f, -448.0f, 448.0f); }
                    int w = __builtin_amdgcn_cvt_pk_fp8_f32(h[0], h[1], 0, false); w = __builtin_amdgcn_cvt_pk_fp8_f32(h[2], h[3], w, true);
                    *(unsigned*)(O + (size_t)(row0 + ai * HALF + m * 16) * ldc + col0 + 16 * n) = (unsigned)w; }
    }
};
struct EpiBf16S {
    static constexpr bool PERM = false, AFTER_DRAIN = false;
    bf16_t* O; int ldc; float sc;
    DI void operator()(const f32x4 (&acc)[2][2][4][2], const Unit& u, int wr, int wc, int fr, int fq) const {
        const int row0 = u.pm * BM + wr * 64 + fr, col0 = u.pn * BM + wc * 32 + 4 * fq;
#pragma unroll
        for (int ai = 0; ai < 2; ++ai)
#pragma unroll
            for (int m = 0; m < 4; ++m) { bf16_t* rowp = O + (size_t)(row0 + ai * HALF + m * 16) * ldc + col0;
#pragma unroll
                for (int bj = 0; bj < 2; ++bj)
#pragma unroll
                    for (int n = 0; n < 2; ++n) { const f32x4 v = acc[ai][bj][m][n] * sc; u32x2 w; w.x = pk2(v[0], v[1]); w.y = pk2(v[2], v[3]); *(u32x2*)(rowp + bj * HALF + n * 16) = w; } }
    }
};
template <int MODE> struct EpiLora {
    static constexpr bool PERM = true, AFTER_DRAIN = false;
    const float* vec; float* Of; bf16_t* Ob;
    DI void operator()(const f32x4 (&acc)[2][2][4][2], const Unit& u, int wr, int wc, int fr, int fq) const {
        const int row0 = u.pm * BM + wr * 64 + fr, col0 = u.pn * BM + wc * 32 + 8 * fq;
#pragma unroll
        for (int bj = 0; bj < 2; ++bj) {
            f32x4 b0 = (f32x4){0.f, 0.f, 0.f, 0.f}, b1 = b0;
            if (MODE < 2) { b0 = *(const f32x4*)(vec + col0 + bj * HALF); b1 = *(const f32x4*)(vec + col0 + bj * HALF + 4); }
#pragma unroll
            for (int ai = 0; ai < 2; ++ai)
#pragma unroll
                for (int m = 0; m < 4; ++m) { const size_t o = (size_t)(row0 + ai * HALF + m * 16) * RW + col0 + bj * HALF;
                    f32x4 v0 = acc[ai][bj][m][0] + b0, v1 = acc[ai][bj][m][1] + b1;
                    if (MODE == 2) { u32x4 w; w.x = pk2(v0[0], v0[1]); w.y = pk2(v0[2], v0[3]); w.z = pk2(v1[0], v1[1]); w.w = pk2(v1[2], v1[3]); *(u32x4*)(Ob + o) = w; }
                    else {
#pragma unroll
                        for (int j = 0; j < 4; ++j) {
                            if (MODE == 0) { v0[j] = __expf(-__expf(-(fmaxf(-v0[j], 0.f) + __logf(1.0f + __expf(-fabsf(v0[j])))) - 0.5f)); v1[j] = __expf(-__expf(-(fmaxf(-v1[j], 0.f) + __logf(1.0f + __expf(-fabsf(v1[j])))) - 0.5f)); }
                            else { v0[j] = 1.0f / (1.0f + __expf(-v0[j])); v1[j] = 1.0f / (1.0f + __expf(-v1[j])); } }
                        *(f32x4*)(Of + o) = v0; *(f32x4*)(Of + o + 4) = v1; } }
        }
    }
};
struct EpiSoftmax {
    static constexpr bool PERM = true, AFTER_DRAIN = true;
    bf16_t* P; float scale2;
    DI void fused(f32x4 (&acc)[2][2][4][2], const Unit& u, int wr, int wc, int fr, int fq, LAS unsigned char* lds, int wid, int lane) const {
        LAS float* PM = (LAS float*)lds;
        LAS float* PS = (LAS float*)(lds + 4096);
        float mx[2][4];
#pragma unroll
        for (int ai = 0; ai < 2; ++ai)
#pragma unroll
            for (int m = 0; m < 4; ++m) { float v = -3.0e38f;
#pragma unroll
                for (int bj = 0; bj < 2; ++bj)
#pragma unroll
                    for (int n = 0; n < 2; ++n)
#pragma unroll
                        for (int j = 0; j < 4; ++j) v = fmaxf(v, acc[ai][bj][m][n][j]);
                v = fmaxf(v, __shfl_xor(v, 16)); v = fmaxf(v, __shfl_xor(v, 32));
                if (fq == 0) PM[(ai * HALF + wr * 64 + m * 16 + fr) * 4 + wc] = v; }
        asm volatile("s_waitcnt lgkmcnt(0)" ::: "memory"); __builtin_amdgcn_s_barrier(); asm volatile("" ::: "memory");
#pragma unroll
        for (int ai = 0; ai < 2; ++ai)
#pragma unroll
            for (int m = 0; m < 4; ++m) { const int r = ai * HALF + wr * 64 + m * 16 + fr; const f32x4 pm = *(const LAS f32x4*)(PM + r * 4);
                const float mxv = fmaxf(fmaxf(pm[0], pm[1]), fmaxf(pm[2], pm[3])) * scale2; mx[ai][m] = mxv; float s = 0.f;
#pragma unroll
                for (int bj = 0; bj < 2; ++bj)
#pragma unroll
                    for (int n = 0; n < 2; ++n)
#pragma unroll
                        for (int j = 0; j < 4; ++j) { const float e = __builtin_amdgcn_exp2f(acc[ai][bj][m][n][j] * scale2 - mxv); acc[ai][bj][m][n][j] = e; s += e; }
                s += __shfl_xor(s, 16); s += __shfl_xor(s, 32);
                if (fq == 0) PS[r * 4 + wc] = s; }
        asm volatile("s_waitcnt lgkmcnt(0)" ::: "memory"); __builtin_amdgcn_s_barrier(); asm volatile("" ::: "memory");
        bf16_t* base = P + (size_t)u.z * SEQ * NMEM;
        const int col0 = wc * 32 + 8 * fq;
#pragma unroll
        for (int ai = 0; ai < 2; ++ai)
#pragma unroll
            for (int m = 0; m < 4; ++m) { const int r = ai * HALF + wr * 64 + m * 16 + fr; const f32x4 ps = *(const LAS f32x4*)(PS + r * 4);
                const float inv = 1.0f / ((ps[0] + ps[1]) + (ps[2] + ps[3]));
                bf16_t* rowp = base + (size_t)(u.pm * BM + r) * NMEM + col0;
#pragma unroll
                for (int bj = 0; bj < 2; ++bj) { const f32x4 v0 = acc[ai][bj][m][0] * inv, v1 = acc[ai][bj][m][1] * inv;
                    u32x4 w; w.x = pk2(v0[0], v0[1]); w.y = pk2(v0[2], v0[3]); w.z = pk2(v1[0], v1[1]); w.w = pk2(v1[2], v1[3]);
                    *(u32x4*)(rowp + bj * HALF) = w; } }
        (void)mx; (void)wid; (void)lane;
    }
};
}

#define XB_TMO      128
#define XB_XCNT(j)  (256  + 64 * (j))
#define XB_XSUB(j)  (1280 + 64 * (j))
#define XB_XGEN(j)  (2304 + 64 * (j))
#define XB_TOP      3328
#define XB_TOPGEN   3392
#define XCD_BAR_WORDS 3456
#define XB_SPIN_CAP (1u << 22)
DI unsigned xb_ld(unsigned* p)              { return __hip_atomic_load(p, __ATOMIC_RELAXED, __HIP_MEMORY_SCOPE_AGENT); }
DI unsigned xb_add(unsigned* p, unsigned v) { return __hip_atomic_fetch_add(p, v, __ATOMIC_RELAXED, __HIP_MEMORY_SCOPE_AGENT); }
DI unsigned xb_xcc_id() { return (unsigned)__builtin_amdgcn_s_getreg((3 << 11) | 20) & 0xFu; }
#define XB_SPIN(cond, bar) do { unsigned _sp = 0; while (cond) { __builtin_amdgcn_s_sleep(1); \
    if ((++_sp & 255u) == 0u) { if (xb_ld(&(bar)[XB_TMO])) break; if (_sp > XB_SPIN_CAP) { atomicAdd(&(bar)[XB_TMO], 1u); break; } } } } while (0)
struct XcdBarrier { unsigned* bar; unsigned x; volatile LAS unsigned* st; int wave; };
DI XcdBarrier xcd_barrier_post(unsigned* bar, volatile LAS unsigned* st, int wave) {
    XcdBarrier b; b.bar = bar; b.x = xb_xcc_id(); b.st = st; b.wave = wave;
    if (wave == 0 && lane_id() == 0) (void)xb_add(&bar[XB_XCNT(b.x)], 1u);
    return b;
}
DI void xcd_barrier_complete(unsigned* bar, unsigned x, unsigned& nloc, unsigned& nx) {
    const unsigned G = gridDim.x * gridDim.y * gridDim.z;
    unsigned sum, cnt, mine, sp = 0u;
    for (;;) {
        sum = 0u; cnt = 0u; mine = 0u;
#pragma unroll
        for (unsigned j = 0; j < 16; ++j) { const unsigned c = xb_ld(&bar[XB_XCNT(j)]); sum += c; cnt += (c > 0u) ? 1u : 0u; mine = (j == x) ? c : mine; }
        if (sum == G) break;
        __builtin_amdgcn_s_sleep(1);
        if ((++sp & 255u) == 0u) { if (xb_ld(&bar[XB_TMO])) break; if (sp > XB_SPIN_CAP) { atomicAdd(&bar[XB_TMO], 1u); break; } }
    }
    nloc = mine > 0u ? mine : 1u; nx = cnt > 0u ? cnt : 1u;
}
DI void xcd_barrier(const XcdBarrier& b) {
    asm volatile("s_waitcnt vmcnt(0)" ::: "memory");
    __syncthreads();
    if (b.wave == 0 && lane_id() == 0) {
        unsigned* bar = b.bar;
        __builtin_amdgcn_s_waitcnt(0);
        unsigned nloc = b.st[0], nx = b.st[1];
        if (nloc == 0u) { xcd_barrier_complete(bar, b.x, nloc, nx); b.st[0] = nloc; b.st[1] = nx; }
        const unsigned old = xb_add(&bar[XB_XSUB(b.x)], 1u);
        const unsigned gen = old / nloc;
        if (old + 1u == (gen + 1u) * nloc) {
            __builtin_amdgcn_fence(__ATOMIC_RELEASE, "agent");
            asm volatile("s_waitcnt vmcnt(0)" ::: "memory");
            const unsigned og = xb_add(&bar[XB_TOP], 1u);
            const unsigned tg = og / nx;
            if (og + 1u == (tg + 1u) * nx) xb_add(&bar[XB_TOPGEN], 1u);
            else XB_SPIN(xb_ld(&bar[XB_TOPGEN]) == tg, bar);
            __builtin_amdgcn_fence(__ATOMIC_ACQUIRE, "agent");
            xb_add(&bar[XB_XGEN(b.x)], 1u);
            asm volatile("s_waitcnt vmcnt(0)" ::: "memory");
        } else {
            XB_SPIN(xb_ld(&bar[XB_XGEN(b.x)]) == gen, bar);
            __builtin_amdgcn_fence(__ATOMIC_ACQUIRE, "agent");
            asm volatile("s_waitcnt vmcnt(0)" ::: "memory");
        }
    }
    __syncthreads();
}

constexpr int NWAVES = 8, NTHR = 512;
constexpr int RING_BYTES = 131072;
constexpr int LDS_BYTES = 147456;
constexpr int MISC_OFF = LDS_BYTES - 1024;
constexpr int CW_BAR = 4096;

struct Args { const float* in[35]; float* out; unsigned char* ws; int ph_lo, ph_hi; };
typedef const __attribute__((address_space(4))) Args CArgs;
enum { I_X = 0, I_MEM, I_F1PRE, I_F1G, I_F1U, I_F1D, I_F1POST, I_MIXPRE, I_WIN, I_FBIAS, I_MU, I_W0, I_WUP, I_A0, I_AUP, I_GUP, I_KK, I_KA, I_RK, I_LNW, I_LNB,
       I_WOUT, I_MIXPOST, I_XPRE, I_MEMG, I_WQ, I_WK, I_WV, I_WO, I_XPOST, I_F2PRE, I_F2G, I_F2U, I_F2D, I_F2POST };

DI float wave_sum(float v) {
#pragma unroll
    for (int o = 1; o < 64; o <<= 1) v += __shfl_xor(v, o);
    return v;
}

struct CvtJob { const float* W; const float* gk; int ldw, K, Kpad, col0, ncols; bf16* dst; int ldk, row0, mode, f8; };
DI void cvt_item(const CvtJob& J, int item, LAS float* scr, int lane) {
    const int nblk = (J.ncols + 63) >> 6, kb = item / nblk, nb = item - kb * nblk, k0 = kb * 64, n0 = nb * 64;
    const int nvalid = J.ncols - n0;
    const int c4 = lane & 15, kr = lane >> 4;
    f32x4 v[16];
    if (nvalid >= 64 && k0 + 64 <= J.K) {
        const GAS f32x4* src = (const GAS f32x4*)(J.W + (size_t)(k0 + kr) * J.ldw + J.col0 + n0 + 4 * c4); const size_t rs = (size_t)J.ldw;
#pragma unroll
        for (int i = 0; i < 16; ++i) v[i] = src[(size_t)i * rs];
    } else {
#pragma unroll
        for (int i = 0; i < 16; ++i) { const int k = k0 + 4 * i + kr;
            v[i] = (4 * c4 < nvalid && k < J.K) ? *(const GAS f32x4*)(J.W + (size_t)k * J.ldw + J.col0 + n0 + 4 * c4) : (f32x4){0.f, 0.f, 0.f, 0.f}; }
    }
    if (J.gk) {
#pragma unroll
        for (int i = 0; i < 16; ++i) { const int k = k0 + 4 * i + kr; const float gg = k < J.K ? J.gk[k] : 0.f; v[i] = v[i] * gg; } }
#pragma unroll
    for (int i = 0; i < 16; ++i) { const int k = 4 * i + kr; *(LAS f32x4*)(scr + k * 64 + ((4 * c4) ^ (((k >> 3) & 7) << 2))) = v[i]; }
    asm volatile("s_waitcnt lgkmcnt(0)" ::: "memory");
    if (J.f8) {
#pragma unroll
        for (int j = 0; j < 4; ++j) { const int p = j * 64 + lane, n = p >> 2, c = p & 3;
            unsigned o[4];
#pragma unroll
            for (int q = 0; q < 4; ++q) { const int e = 4 * q; const LAS float* sp = scr + (16 * c + e) * 64 + (n ^ ((2 * c + (e >> 3)) << 2));
                int w = __builtin_amdgcn_cvt_pk_fp8_f32(__builtin_amdgcn_fmed3f(sp[0] * 64.0f, -448.0f, 448.0f), __builtin_amdgcn_fmed3f(sp[64] * 64.0f, -448.0f, 448.0f), 0, false);
                w = __builtin_amdgcn_cvt_pk_fp8_f32(__builtin_amdgcn_fmed3f(sp[128] * 64.0f, -448.0f, 448.0f), __builtin_amdgcn_fmed3f(sp[192] * 64.0f, -448.0f, 448.0f), w, true); o[q] = (unsigned)w; }
            if (n < nvalid) { const int ng = n0 + n; const int drow = (J.mode == 0) ? (J.row0 + ng) : ((ng >> 7) * 256 + (ng & 127) + (J.mode == 2 ? 128 : 0));
                *(GAS u32x4*)((unsigned char*)J.dst + (size_t)drow * J.ldk + k0 + 16 * c) = (u32x4){o[0], o[1], o[2], o[3]}; } }
    } else {
#pragma unroll
    for (int j = 0; j < 8; ++j) { const int p = j * 64 + lane, n = p >> 3, c = p & 7;
        const LAS float* s = scr + (8 * c) * 64 + (n ^ (c << 2));
        u32x4 o; o.x = pk2(s[0], s[64]); o.y = pk2(s[128], s[192]); o.z = pk2(s[256], s[320]); o.w = pk2(s[384], s[448]);
        if (n < nvalid) { const int ng = n0 + n; const int drow = (J.mode == 0) ? (J.row0 + ng) : ((ng >> 7) * 256 + (ng & 127) + (J.mode == 2 ? 128 : 0));
            *(GAS u32x4*)(J.dst + (size_t)drow * J.ldk + k0 + 8 * c) = o; } }
    }
    asm volatile("s_waitcnt lgkmcnt(0)" ::: "memory");
}
constexpr int CI_FF = 64 * 172, CI_INA = 64 * 96, CI_INC = 64 * 7, CI_IND = 64, CI_SQ = 64 * 64, CI_LORA = 4 * 32;
constexpr int CVT_NITEMS = 6 * CI_FF + 2 * CI_INA + CI_INC + CI_IND + 5 * CI_SQ + 3 * CI_LORA;
constexpr int CVT_EARLY = 3 * CI_FF + 2 * CI_INA + CI_INC + CI_IND + 2 * CI_SQ + 3 * CI_LORA;
DI bool cvt_pick(CArgs& a, int it, CvtJob& J, int& local) {
    unsigned char* ws = a.ws;
#define CJ(cnt, Wp, ldw_, K_, Kpad_, col0_, ncols_, dst_, ldk_, row0_, mode_) \
    if (it < (cnt)) { J.W = (Wp); J.ldw = (ldw_); J.K = (K_); J.Kpad = (Kpad_); J.col0 = (col0_); J.ncols = (ncols_); J.dst = (bf16*)(ws + (dst_)); J.ldk = (ldk_); J.row0 = (row0_); J.mode = (mode_) & 3; J.f8 = ((mode_) >> 2) & 3; J.gk = ((mode_) >> 4) == 1 ? a.in[I_MIXPRE] : ((mode_) >> 4) == 2 ? a.in[I_XPRE] : nullptr; local = it; return true; } it -= (cnt);
    CJ(CI_FF, a.in[I_F1G], FF, D, D, 0, FF, WS_F1GU, D, 0, 1)
    CJ(CI_FF, a.in[I_F1U], FF, D, D, 0, FF, WS_F1GU, D, 0, 2)
    CJ(CI_FF, a.in[I_F1D], D, FF, FF, 0, D, WS_F1D, FF, 0, 0)
    CJ(CI_INA, a.in[I_WIN], IN_COLS, D, D, 0, 6144, WS_W_IN, D, 0, 0 + 16)
    CJ(CI_INA, a.in[I_WIN], IN_COLS, D, D, 6160, 6144, WS_W_IN, D, PC_RKV, 0 + 16)
    CJ(CI_INC, a.in[I_WIN], IN_COLS, D, D, 12304, 448, WS_W_IN, D, PC_LORA, 0 + 16)
    CJ(CI_IND, a.in[I_WIN], IN_COLS, D, D, 6144, 16, WS_W_IN, D, PC_FL, 0 + 16)
    CJ(CI_SQ, a.in[I_WK], D, D, D, 0, D, WS_WK, D, 0, 0)
    CJ(CI_SQ, a.in[I_WV], D, D, D, 0, D, WS_WV, D, 0, 0)
    CJ(CI_LORA, a.in[I_WUP], RW, 96, LORA_K, 0, RW, WS_LORAW, LORA_K, 0, 0)
    CJ(CI_LORA, a.in[I_AUP], RW, 96, LORA_K, 0, RW, WS_LORAW, LORA_K, RW, 0)
    CJ(CI_LORA, a.in[I_GUP], RW, 256, LORA_K, 0, RW, WS_LORAW, LORA_K, 2 * RW, 0)
    CJ(CI_SQ, a.in[I_WOUT], D, D, D, 0, D, WS_W_OUT, D, 0, 0)
    CJ(CI_SQ, a.in[I_WQ], D, D, D, 0, D, WS_WQ, D, 0, 0 + 32)
    CJ(CI_SQ, a.in[I_WO], D, D, D, 0, D, WS_WO, D, 0, 0)
    CJ(CI_FF, a.in[I_F2G], FF, D, D, 0, FF, WS_F2GU, D, 0, 1 + 4)
    CJ(CI_FF, a.in[I_F2U], FF, D, D, 0, FF, WS_F2GU, D, 0, 2 + 4)
    CJ(CI_FF, a.in[I_F2D], D, FF, FF, 0, D, WS_F2D, FF, 0, 0 + 4)
#undef CJ
    return false;
}
DI void rms_row_to_bf16(const float* xrow, const float* g, bf16* orow, int lane) {
    const GAS f32x4* xr = (const GAS f32x4*)xrow + lane; const GAS f32x4* gr = (const GAS f32x4*)g + lane;
    f32x4 v[16]; float s = 0.f;
#pragma unroll
    for (int j = 0; j < 16; ++j) { v[j] = xr[64 * j]; s += (v[j].x * v[j].x + v[j].y * v[j].y) + (v[j].z * v[j].z + v[j].w * v[j].w); }
    const float rstd = 1.0f / sqrtf(wave_sum(s) * (1.0f / D) + RMS_EPS);
    GAS u32x2* o8 = (GAS u32x2*)orow + lane;
#pragma unroll
    for (int j = 0; j < 16; ++j) { const f32x4 gg = gr[64 * j]; u32x2 w; w.x = pk2(v[j].x * rstd * gg.x, v[j].y * rstd * gg.y); w.y = pk2(v[j].z * rstd * gg.z, v[j].w * rstd * gg.w); o8[64 * j] = w; }
}
DI void p0_prologue(CArgs& a, LAS unsigned char* lds, int wave, int lane) {
    LAS float* scr = (LAS float*)(lds + wave * 16384);
    const int gw = blockIdx.x * NWAVES + wave, NGW = gridDim.x * NWAVES;
    if (P0_PARTS & 1) for (int it = CVT_LO + gw; it < CVT_HI; it += NGW) { CvtJob J; int local; if (cvt_pick(a, it, J, local)) cvt_item(J, local, scr, lane); }
    if (P0_PARTS & 2) { bf16* wi = (bf16*)(a.ws + WS_W_IN) + (size_t)12752 * D; const int nchunk = 48 * D / 8;
      for (int i = gw * 64 + lane; i < nchunk; i += NGW * 64) *(GAS u32x4*)(wi + (size_t)i * 8) = (u32x4){0u, 0u, 0u, 0u}; }
    bf16* H = (bf16*)(a.ws + WS_H); bf16* MEMN = (bf16*)(a.ws + WS_MEMN);
    if (P0_PARTS & 4) for (int m = gw; m < M; m += NGW) rms_row_to_bf16(a.in[I_X] + (size_t)m * D, a.in[I_F1PRE], H + (size_t)m * D, lane);
    if (P0_PARTS & 4) for (int m = gw; m < MM; m += NGW) rms_row_to_bf16(a.in[I_MEM] + (size_t)m * D, a.in[I_MEMG], MEMN + (size_t)m * D, lane);
}

DI void tail_cvt(CArgs& a, LAS unsigned char* lds, int wave, int lane, int first, int count, int r, int nidle) {
    LAS float* scr = (LAS float*)(lds + wave * 16384);
    for (int it = r * NWAVES + wave; it < count; it += nidle * NWAVES) { CvtJob J; int local; if (cvt_pick(a, first + it, J, local)) cvt_item(J, local, scr, lane); }
}
constexpr int CVT_TAIL = 6144;
template <bool H8, bool XIN32, bool XOUT32> DI void seam_phase(const void* xin_, const bf16* Y, void* xout_, bf16* H, const float* g_post, const float* g_pre, float alpha, int wave, int lane, float* rstd_out = nullptr) {
    const int gw = blockIdx.x * NWAVES + wave, NGW = gridDim.x * NWAVES;
    for (int m = gw; m < M; m += NGW) {
        const GAS u32x4* yr = (const GAS u32x4*)(Y + (size_t)m * D) + lane;
        float y[8][8], x[8][8]; float s = 0.f;
#pragma unroll
        for (int j = 0; j < 8; ++j) { const u32x4 yy = yr[64 * j];
#pragma unroll
            for (int e = 0; e < 4; ++e) { y[j][2 * e] = bflo(yy[e]); y[j][2 * e + 1] = bfhi(yy[e]); } }
        if constexpr (XIN32) { const GAS f32x4* xr = (const GAS f32x4*)((const float*)xin_ + (size_t)m * D) + 2 * lane;
#pragma unroll
            for (int j = 0; j < 8; ++j) { const f32x4 a0 = xr[128 * j], a1 = xr[128 * j + 1]; x[j][0] = a0[0]; x[j][1] = a0[1]; x[j][2] = a0[2]; x[j][3] = a0[3]; x[j][4] = a1[0]; x[j][5] = a1[1]; x[j][6] = a1[2]; x[j][7] = a1[3]; } }
        else { const GAS u32x4* xr = (const GAS u32x4*)((const bf16*)xin_ + (size_t)m * D) + lane;
#pragma unroll
            for (int j = 0; j < 8; ++j) { const u32x4 xx = xr[64 * j];
#pragma unroll
                for (int e = 0; e < 4; ++e) { x[j][2 * e] = bflo(xx[e]); x[j][2 * e + 1] = bfhi(xx[e]); } } }
#pragma unroll
        for (int j = 0; j < 8; ++j)
#pragma unroll
            for (int e = 0; e < 8; ++e) s += y[j][e] * y[j][e];
        const float ry = alpha / sqrtf(wave_sum(s) * (1.0f / D) + RMS_EPS);
        float s2 = 0.f; const GAS f32x4* gp = (const GAS f32x4*)g_post + 2 * lane;
#pragma unroll
        for (int j = 0; j < 8; ++j) { const f32x4 g0 = gp[128 * j], g1 = gp[128 * j + 1];
#pragma unroll
            for (int e = 0; e < 8; ++e) { const float gg = (e < 4) ? g0[e] : g1[e - 4]; x[j][e] = x[j][e] + y[j][e] * ry * gg; s2 += x[j][e] * x[j][e]; }
            if constexpr (XOUT32) { GAS f32x4* xo = (GAS f32x4*)((float*)xout_ + (size_t)m * D) + 2 * lane; xo[128 * j] = (f32x4){x[j][0], x[j][1], x[j][2], x[j][3]}; xo[128 * j + 1] = (f32x4){x[j][4], x[j][5], x[j][6], x[j][7]}; }
            else { u32x4 w; w.x = pk2(x[j][0], x[j][1]); w.y = pk2(x[j][2], x[j][3]); w.z = pk2(x[j][4], x[j][5]); w.w = pk2(x[j][6], x[j][7]); ((GAS u32x4*)((bf16*)xout_ + (size_t)m * D) + lane)[64 * j] = w; } }
        if (g_pre) {
            const float rx = 1.0f / sqrtf(wave_sum(s2) * (1.0f / D) + RMS_EPS);
            if (rstd_out) { if (lane == 0) rstd_out[m] = rx; continue; }
            const GAS f32x4* gq = (const GAS f32x4*)g_pre + 2 * lane;
#pragma unroll
            for (int j = 0; j < 8; ++j) { const f32x4 g0 = gq[128 * j], g1 = gq[128 * j + 1]; float hv[8];
#pragma unroll
                for (int e = 0; e < 8; ++e) hv[e] = x[j][e] * rx * ((e < 4) ? g0[e] : g1[e - 4]);
                if constexpr (H8) {
#pragma unroll
                    for (int e = 0; e < 8; ++e) hv[e] = __builtin_amdgcn_fmed3f(hv[e] * 8.0f, -448.0f, 448.0f);
                    int w0 = __builtin_amdgcn_cvt_pk_fp8_f32(hv[0], hv[1], 0, false); w0 = __builtin_amdgcn_cvt_pk_fp8_f32(hv[2], hv[3], w0, true);
                    int w1 = __builtin_amdgcn_cvt_pk_fp8_f32(hv[4], hv[5], 0, false); w1 = __builtin_amdgcn_cvt_pk_fp8_f32(hv[6], hv[7], w1, true);
                    ((GAS u32x2*)((unsigned char*)H + (size_t)m * D) + lane)[64 * j] = (u32x2){(unsigned)w0, (unsigned)w1};
                } else { u32x4 w; w.x = pk2(hv[0], hv[1]); w.y = pk2(hv[2], hv[3]); w.z = pk2(hv[4], hv[5]); w.w = pk2(hv[6], hv[7]); ((GAS u32x4*)(H + (size_t)m * D) + lane)[64 * j] = w; } }
        }
    }
}

DI float fox_logsig(float z) { return (z >= 0.f) ? -log1pf(expf(-z)) : (z - log1pf(expf(z))); }
DI void fox_cumsum_phase(CArgs& a, LAS unsigned char* lds, int wave, int lane) {
    const float* FL = (const float*)(a.ws + WS_FL); float* C = (float*)(a.ws + WS_C);
    LAS float* red = (LAS float*)lds;
    const int tid_ = wave * 64 + lane;
    for (int u = blockIdx.x; u < BATCH * FOXH * 4; u += gridDim.x) {
        const int bh = u >> 2, seg = u & 3, b = bh >> 4, h = bh & 15; const float bias = a.in[I_FBIAS][h];
        const float* fl = FL + (size_t)b * SEQ * 16 + h;
        const float own = fox_logsig(fl[(size_t)(512 * seg + tid_) * 16] + bias);
        float before = 0.f;
        for (int s = 0; s < seg; ++s) before += fox_logsig(fl[(size_t)(512 * s + tid_) * 16] + bias);
        float incl = own;
#pragma unroll
        for (int o = 1; o < 64; o <<= 1) { const float t = __shfl_up(incl, o); if (lane >= o) incl += t; }
        float bsum = before;
#pragma unroll
        for (int o = 32; o > 0; o >>= 1) bsum += __shfl_xor(bsum, o);
        __syncthreads();
        if (lane == 63) red[wave] = incl;
        if (lane == 0) red[8 + wave] = bsum;
        __syncthreads();
        float off = 0.f;
#pragma unroll
        for (int w = 0; w < 8; ++w) { off += red[8 + w]; if (w < wave) off += red[w]; }
        C[(size_t)bh * SEQ + 512 * seg + tid_] = (off + incl) * LOG2E;
    }
}
DI void lora_act_phase(CArgs& a, int wave, int lane) {
    const int gw = blockIdx.x * NWAVES + wave, NGW = gridDim.x * NWAVES;
    const bf16* PROJ = (const bf16*)(a.ws + WS_BIG); bf16* AL = (bf16*)(a.ws + WS_ALORA); const float* mu = a.in[I_MU] + 6144;
    for (int m = gw; m < M; m += NGW) {
        const bool has_prev = (m & (SEQ - 1)) != 0; const bf16* cur = PROJ + (size_t)m * NIN + PC_LORA; bf16* o = AL + (size_t)m * ALD;
        if (lane < 56) {
            const int j = 8 * lane; const u32x4 c4 = *(const GAS u32x4*)(cur + j); u32x4 p4 = (u32x4){0u, 0u, 0u, 0u}; if (has_prev) p4 = *(const GAS u32x4*)(cur + j - NIN);
            const f32x4 m0 = *(const GAS f32x4*)(mu + j), m1 = *(const GAS f32x4*)(mu + j + 4);
            float z[8];
#pragma unroll
            for (int e = 0; e < 4; ++e) { const float c0 = bflo(c4[e]), c1 = bfhi(c4[e]), p0 = bflo(p4[e]), p1 = bfhi(p4[e]); const float mm0 = (e < 2) ? m0[2 * e] : m1[2 * e - 4], mm1 = (e < 2) ? m0[2 * e + 1] : m1[2 * e - 3];
                z[2 * e] = c0 + mm0 * (p0 - c0); z[2 * e + 1] = c1 + mm1 * (p1 - c1); }
            int dst;
            if (lane < 12) { dst = j;
#pragma unroll
                for (int e = 0; e < 8; ++e) z[e] = tanhf(z[e]); }
            else if (lane < 24) dst = 256 + (j - 96);
            else { dst = 512 + (j - 192);
#pragma unroll
                for (int e = 0; e < 8; ++e) z[e] = 1.0f / (1.0f + __expf(-z[e])); }
            u32x4 w; w.x = pk2(z[0], z[1]); w.y = pk2(z[2], z[3]); w.z = pk2(z[4], z[5]); w.w = pk2(z[6], z[7]); *(GAS u32x4*)(o + dst) = w;
        }
        if (lane < 40) { const int dst = (lane < 20) ? (96 + 8 * lane) : (352 + 8 * (lane - 20)); *(GAS u32x4*)(o + dst) = (u32x4){0u, 0u, 0u, 0u}; }
    }
}
DI float lane8_sum(float x) {
    x += __builtin_bit_cast(float, __builtin_amdgcn_update_dpp(0, __builtin_bit_cast(int, x), 0xB1, 0xf, 0xf, false));
    x += __builtin_bit_cast(float, __builtin_amdgcn_update_dpp(0, __builtin_bit_cast(int, x), 0x4E, 0xf, 0xf, false));
    x += __builtin_bit_cast(float, __builtin_amdgcn_update_dpp(0, __builtin_bit_cast(int, x), 0x141, 0xf, 0xf, false));
    return x;
}
DI void rwkv_post_phase(CArgs& a, int wave, int lane) {
    const int gw = blockIdx.x * NWAVES + wave, NGW = gridDim.x * NWAVES;
    const float* YR = (const float*)(a.ws + WS_YR); const bf16* PROJ = (const bf16*)(a.ws + WS_BIG); const bf16* G_ = (const bf16*)(a.ws + WS_G); const float* BON = (const float*)(a.ws + WS_BON);
    bf16* MIX = (bf16*)(a.ws + WS_ACT2);
    for (int task = gw; task < M * 4; task += NGW) {
        const int m = task >> 2, c = (task & 3) * 512 + 8 * lane, h = c >> 6; const bool has_prev = (m & (SEQ - 1)) != 0;
        const f32x4 y0 = *(const GAS f32x4*)(YR + (size_t)m * RW + c), y1 = *(const GAS f32x4*)(YR + (size_t)m * RW + c + 4);
        const bf16* pv = PROJ + (size_t)m * NIN + PC_RKV + 4096 + c;
        const u32x4 vc = *(const GAS u32x4*)pv; u32x4 vp = (u32x4){0u, 0u, 0u, 0u}; if (has_prev) vp = *(const GAS u32x4*)(pv - NIN);
        const u32x4 gg = *(const GAS u32x4*)(G_ + (size_t)m * RW + c);
        const float bon = BON[(size_t)m * RH + h];
        const f32x4 mu0 = *(const GAS f32x4*)(a.in[I_MU] + 4096 + c), mu1 = *(const GAS f32x4*)(a.in[I_MU] + 4096 + c + 4);
        const f32x4 lw0 = *(const GAS f32x4*)(a.in[I_LNW] + c), lw1 = *(const GAS f32x4*)(a.in[I_LNW] + c + 4), lb0 = *(const GAS f32x4*)(a.in[I_LNB] + c), lb1 = *(const GAS f32x4*)(a.in[I_LNB] + c + 4);
        float y[8] = {y0[0], y0[1], y0[2], y0[3], y1[0], y1[1], y1[2], y1[3]};
        float s = 0.f;
#pragma unroll
        for (int e = 0; e < 8; ++e) s += y[e];
        const float mean = lane8_sum(s) * (1.0f / 64.0f); float q = 0.f;
#pragma unroll
        for (int e = 0; e < 8; ++e) { y[e] -= mean; q += y[e] * y[e]; }
        const float rstd = 1.0f / sqrtf(lane8_sum(q) * (1.0f / 64.0f) + GN_EPS);
        float o[8];
#pragma unroll
        for (int e = 0; e < 8; ++e) { const float vcur = (e & 1) ? bfhi(vc[e >> 1]) : bflo(vc[e >> 1]), vprev = (e & 1) ? bfhi(vp[e >> 1]) : bflo(vp[e >> 1]);
            const float mue = (e < 4) ? mu0[e] : mu1[e - 4], lwe = (e < 4) ? lw0[e] : lw1[e - 4], lbe = (e < 4) ? lb0[e] : lb1[e - 4];
            const float v = vcur + mue * (vprev - vcur); const float ge = (e & 1) ? bfhi(gg[e >> 1]) : bflo(gg[e >> 1]);
            o[e] = (y[e] * rstd * lwe + lbe + bon * v) * ge; }
        u32x4 w; w.x = pk2(o[0], o[1]); w.y = pk2(o[2], o[3]); w.z = pk2(o[4], o[5]); w.w = pk2(o[6], o[7]);
        *(GAS u32x4*)(MIX + (size_t)m * D + RW + c) = w;
    }
}

DI float row16_sum(float x) {
    x += __builtin_bit_cast(float, __builtin_amdgcn_update_dpp(0, __builtin_bit_cast(int, x), 0x128, 0xf, 0xf, false));
    x += __builtin_bit_cast(float, __builtin_amdgcn_update_dpp(0, __builtin_bit_cast(int, x), 0x124, 0xf, 0xf, false));
    x += __builtin_bit_cast(float, __builtin_amdgcn_update_dpp(0, __builtin_bit_cast(int, x), 0x122, 0xf, 0xf, false));
    x += __builtin_bit_cast(float, __builtin_amdgcn_update_dpp(0, __builtin_bit_cast(int, x), 0x121, 0xf, 0xf, false));
    return x;
}
DI float row8_sum(float x) {
    x += __builtin_bit_cast(float, __builtin_amdgcn_update_dpp(0, __builtin_bit_cast(int, x), 0x141, 0xf, 0xf, false));
    x += __builtin_bit_cast(float, __builtin_amdgcn_update_dpp(0, __builtin_bit_cast(int, x), 0x1B, 0xf, 0xf, false));
    x += __builtin_bit_cast(float, __builtin_amdgcn_update_dpp(0, __builtin_bit_cast(int, x), 0xB1, 0xf, 0xf, false));
    return x;
}
constexpr int SC_T = 16;
constexpr int SC_R = 0, SC_W = 4096, SC_KM = 8192, SC_KK = 12288, SC_KKA = 16384, SC_V = 20480, SC_BUF = 22528 + 512;
constexpr int SC_YB = 3 * SC_BUF, SC_CVT = 73728;
static_assert(SC_YB + 2 * 2048 <= SC_CVT && SC_CVT + 4 * 16384 <= MISC_OFF, "scan LDS map");
DI void fox4_run(CArgs& a, int u, LAS unsigned char* lds, volatile LAS unsigned* cnt, unsigned& target, int w4, int lane);
DI void scan_unit(CArgs& a, int unit, bool do_cvt, LAS unsigned char* lds, volatile LAS unsigned* cntw, int tid, int wave, int lane) {
    const unsigned cbase = *cntw; const unsigned cbase2 = cntw[4];
    __syncthreads();
    if (wave >= 4) {
        if (do_cvt) { LAS float* scr = (LAS float*)(lds + SC_CVT + (wave - 4) * 16384); const int cw = blockIdx.x * 4 + (wave - 4), NCW = gridDim.x * 4;
            for (int it = CVT_EARLY + (gridDim.x == 256 ? 2 * CVT_TAIL : 0) + cw; it < CVT_NITEMS; it += NCW) { CvtJob J; int local; if (cvt_pick(a, it, J, local)) cvt_item(J, local, scr, lane); }
            __builtin_amdgcn_s_setprio(FOX_PRIO); unsigned tgt2 = cbase2; for (int fu = blockIdx.x; fu < 256; fu += gridDim.x) fox4_run(a, fu, lds, cntw + 4, tgt2, wave - 4, lane); __builtin_amdgcn_s_setprio(0); }
    } else {
    __builtin_amdgcn_s_setprio(3);
    const int half = unit & 1, bh = unit >> 1, b = bh >> 5, h = bh & 31;
    const bf16* PROJ = (const bf16*)(a.ws + WS_BIG); const float* AA = (const float*)(a.ws + WS_AA); const float* WD = (const float*)(a.ws + WS_WDEC);
    float* YR = (float*)(a.ws + WS_YR); float* BON = (float*)(a.ws + WS_BON);
    const int rp = lane >> 4, g = lane & 15, rowA = 8 * wave + 2 * rp;
    unsigned target = cbase;
#define SC_ARRIVE() do { asm volatile("s_waitcnt lgkmcnt(0)" ::: "memory"); if (lane == 0) __hip_atomic_fetch_add((LAS unsigned*)cntw, 1u, __ATOMIC_RELAXED, __HIP_MEMORY_SCOPE_WORKGROUP); target += 4u; } while (0)
#define SC_WAIT() do { while ((int)(__hip_atomic_load((LAS unsigned*)cntw, __ATOMIC_RELAXED, __HIP_MEMORY_SCOPE_WORKGROUP) - target) < 0) { } asm volatile("" ::: "memory"); } while (0)
#define SC_BAR() do { asm volatile("s_waitcnt lgkmcnt(0)" ::: "memory"); if (lane == 0) __hip_atomic_fetch_add((LAS unsigned*)cntw, 1u, __ATOMIC_RELAXED, __HIP_MEMORY_SCOPE_WORKGROUP); target += 4u; \
        while ((int)(__hip_atomic_load((LAS unsigned*)cntw, __ATOMIC_RELAXED, __HIP_MEMORY_SCOPE_WORKGROUP) - target) < 0) { } asm volatile("" ::: "memory"); } while (0)
    const int st = tid >> 4, c4 = h * 64 + 4 * g;
    const bf16* gP = PROJ + (size_t)(b * SEQ + st) * NIN + PC_RKV + c4; const float* gA = AA + (size_t)(b * SEQ + st) * RW + c4; const float* gW = WD + (size_t)(b * SEQ + st) * RW + c4;
    const f32x4 mur = *(const GAS f32x4*)(a.in[I_MU] + c4), muk = *(const GAS f32x4*)(a.in[I_MU] + 2048 + c4), muv = *(const GAS f32x4*)(a.in[I_MU] + 4096 + c4);
    const f32x4 pkk = *(const GAS f32x4*)(a.in[I_KK] + c4), pka = *(const GAS f32x4*)(a.in[I_KA] + c4), prk = *(const GAS f32x4*)(a.in[I_RK] + c4);
    u32x2 rc, kc, vc, rp_, kp, vp; f32x4 av, wv;
#define SC_LOAD(ck) do { const size_t _o = (size_t)(ck) * SC_T; const bf16* _p = gP + _o * NIN; rc = *(const GAS u32x2*)_p; kc = *(const GAS u32x2*)(_p + 2048); vc = *(const GAS u32x2*)(_p + 4096); \
        if ((ck) * SC_T + st > 0) { rp_ = *(const GAS u32x2*)(_p - NIN); kp = *(const GAS u32x2*)(_p - NIN + 2048); vp = *(const GAS u32x2*)(_p - NIN + 4096); } else { rp_ = (u32x2){0u, 0u}; kp = rp_; vp = rp_; } \
        av = *(const GAS f32x4*)(gA + _o * RW); wv = *(const GAS f32x4*)(gW + _o * RW); } while (0)
#define SC_UNP(u) ((f32x4){bflo((u).x), bfhi((u).x), bflo((u).y), bfhi((u).y)})
#define SC_STORE(bufo, ck) do { \
        f32x4 r = SC_UNP(rc), k = SC_UNP(kc), v = SC_UNP(vc); r = r + mur * (SC_UNP(rp_) - r); k = k + muk * (SC_UNP(kp) - k); v = v + muv * (SC_UNP(vp) - v); \
        f32x4 kk = k * pkk; const float n2 = row16_sum((kk.x * kk.x + kk.y * kk.y) + (kk.z * kk.z + kk.w * kk.w)); kk = kk * __builtin_amdgcn_rsqf(fmaxf(n2, 1e-24f)); \
        const f32x4 km = k * (1.0f + (av - 1.0f) * pka); const f32x4 rk = r * km * prk; const float bon = row16_sum((rk.x + rk.y) + (rk.z + rk.w)); \
        LAS unsigned char* _b = lds + (bufo) + st * 256 + g * 16; \
        *(LAS f32x4*)(_b + SC_R) = r; *(LAS f32x4*)(_b + SC_W) = wv; *(LAS f32x4*)(_b + SC_KM) = km; *(LAS f32x4*)(_b + SC_KK) = kk; *(LAS f32x4*)(_b + SC_KKA) = kk * av; \
        if ((g >> 3) == half) *(LAS f32x4*)(lds + (bufo) + SC_V + st * 128 + (g & 7) * 16) = v; \
        if (g == 0 && half == 0) BON[(size_t)(b * SEQ + (ck) * SC_T + st) * RH + h] = bon; } while (0)
    const int rq = lane >> 3, g8 = lane & 7, rowQ = 8 * wave + rq;
    float s0 = 0.f, s1 = 0.f, s2 = 0.f, s3 = 0.f, s4 = 0.f, s5 = 0.f, s6 = 0.f, s7 = 0.f;
    constexpr int NCH = SEQ / SC_T;
    SC_LOAD(0); SC_STORE(0, 0); SC_LOAD(1);
    SC_BAR();
    int bcur = 0;
    for (int ck = 0; ck < NCH; ++ck) {
        const int bo = bcur * SC_BUF; const int bnext = (bcur == 2) ? 0 : bcur + 1;
        if (ck + 1 < NCH) { SC_STORE(bnext * SC_BUF, ck + 1); if (ck + 2 < NCH) SC_LOAD(ck + 2); }
        SC_ARRIVE();
        const LAS unsigned char* bp = lds + bo + g8 * 32; const LAS unsigned char* vp_ = lds + bo + SC_V + rowQ * 4; LAS unsigned char* yb = lds + SC_YB + (ck & 1) * 2048 + rowQ * 4;
#define SC_LD(P, t) do { P##kk0 = *(const LAS f32x4*)(bp + SC_KK + (t) * 256); P##kk1 = *(const LAS f32x4*)(bp + SC_KK + (t) * 256 + 16); P##w0 = *(const LAS f32x4*)(bp + SC_W + (t) * 256); P##w1 = *(const LAS f32x4*)(bp + SC_W + (t) * 256 + 16); \
        P##ka0 = *(const LAS f32x4*)(bp + SC_KKA + (t) * 256); P##ka1 = *(const LAS f32x4*)(bp + SC_KKA + (t) * 256 + 16); P##km0 = *(const LAS f32x4*)(bp + SC_KM + (t) * 256); P##km1 = *(const LAS f32x4*)(bp + SC_KM + (t) * 256 + 16); \
        P##r0 = *(const LAS f32x4*)(bp + SC_R + (t) * 256); P##r1 = *(const LAS f32x4*)(bp + SC_R + (t) * 256 + 16); P##v = *(const LAS float*)(vp_ + (t) * 128); } while (0)
#define SC_MUL(d, x, y) asm("v_mul_f32 %0, %1, %2" : "=v"(d) : "v"(x), "v"(y))
#define SC_FMA(d, x, y, z) asm("v_fma_f32 %0, %1, %2, %3" : "=v"(d) : "v"(x), "v"(y), "v"(z))
#define SC_FNMA(d, x, y, z) asm("v_fma_f32 %0, -%1, %2, %3" : "=v"(d) : "v"(x), "v"(y), "v"(z))
#define SC_RED1(P) asm volatile( \
        "v_add_f32 %[d], %[m0], %[m1]\n\tv_mul_f32 %[t0], %[k0], %[v]\n\tv_mul_f32 %[t1], %[k1], %[v]\n\tv_mul_f32 %[t2], %[k2], %[v]\n\tv_mul_f32 %[t3], %[k3], %[v]\n\t" \
        "v_add_f32_dpp %[d], %[d], %[d] row_half_mirror row_mask:0xf bank_mask:0xf\n\tv_mul_f32 %[t4], %[k4], %[v]\n\tv_mul_f32 %[t5], %[k5], %[v]\n\t" \
        "v_add_f32_dpp %[d], %[d], %[d] quad_perm:[3,2,1,0] row_mask:0xf bank_mask:0xf\n\tv_mul_f32 %[t6], %[k6], %[v]\n\tv_mul_f32 %[t7], %[k7], %[v]\n\t" \
        "v_add_f32_dpp %[d], %[d], %[d] quad_perm:[1,0,3,2] row_mask:0xf bank_mask:0xf" \
        : [d] "=&v"(dA), [t0] "=&v"(t0), [t1] "=&v"(t1), [t2] "=&v"(t2), [t3] "=&v"(t3), [t4] "=&v"(t4), [t5] "=&v"(t5), [t6] "=&v"(t6), [t7] "=&v"(t7) \
        : [m0] "v"(m0), [m1] "v"(m1), [v] "v"(P##v), [k0] "v"(P##km0.x), [k1] "v"(P##km0.y), [k2] "v"(P##km0.z), [k3] "v"(P##km0.w), [k4] "v"(P##km1.x), [k5] "v"(P##km1.y), [k6] "v"(P##km1.z), [k7] "v"(P##km1.w))
#define SC_RED2(N) asm volatile( \
        "v_add_f32 %[y], %[a0], %[a1]\n\tv_mul_f32 %[n0], %[s0], %[q0]\n\tv_mul_f32 %[n1], %[s4], %[q4]\n\t" \
        "v_add_f32_dpp %[y], %[y], %[y] row_half_mirror row_mask:0xf bank_mask:0xf\n\tv_fma_f32 %[n0], %[s1], %[q1], %[n0]\n\tv_fma_f32 %[n1], %[s5], %[q5], %[n1]\n\t" \
        "v_add_f32_dpp %[y], %[y], %[y] quad_perm:[3,2,1,0] row_mask:0xf bank_mask:0xf\n\tv_fma_f32 %[n0], %[s2], %[q2], %[n0]\n\tv_fma_f32 %[n1], %[s6], %[q6], %[n1]\n\t" \
        "v_add_f32_dpp %[y], %[y], %[y] quad_perm:[1,0,3,2] row_mask:0xf bank_mask:0xf\n\tv_fma_f32 %[n0], %[s3], %[q3], %[n0]\n\tv_fma_f32 %[n1], %[s7], %[q7], %[n1]" \
        : [y] "=&v"(yA), [n0] "=&v"(m0), [n1] "=&v"(m1) \
        : [a0] "v"(y0), [a1] "v"(y1), [s0] "v"(s0), [s1] "v"(s1), [s2] "v"(s2), [s3] "v"(s3), [s4] "v"(s4), [s5] "v"(s5), [s6] "v"(s6), [s7] "v"(s7), \
          [q0] "v"(N##kk0.x), [q1] "v"(N##kk0.y), [q2] "v"(N##kk0.z), [q3] "v"(N##kk0.w), [q4] "v"(N##kk1.x), [q5] "v"(N##kk1.y), [q6] "v"(N##kk1.z), [q7] "v"(N##kk1.w))
#define SC_RED2L() asm volatile( \
        "v_add_f32 %[y], %[a0], %[a1]\n\ts_nop 1\n\tv_add_f32_dpp %[y], %[y], %[y] row_half_mirror row_mask:0xf bank_mask:0xf\n\ts_nop 1\n\t" \
        "v_add_f32_dpp %[y], %[y], %[y] quad_perm:[3,2,1,0] row_mask:0xf bank_mask:0xf\n\ts_nop 1\n\tv_add_f32_dpp %[y], %[y], %[y] quad_perm:[1,0,3,2] row_mask:0xf bank_mask:0xf" \
        : [y] "=&v"(yA) : [a0] "v"(y0), [a1] "v"(y1))
#define SC_PART(P) do { SC_MUL(m0, s0, P##kk0.x); SC_MUL(m1, s4, P##kk1.x); SC_FMA(m0, s1, P##kk0.y, m0); SC_FMA(m1, s5, P##kk1.y, m1); \
        SC_FMA(m0, s2, P##kk0.z, m0); SC_FMA(m1, s6, P##kk1.z, m1); SC_FMA(m0, s3, P##kk0.w, m0); SC_FMA(m1, s7, P##kk1.w, m1); } while (0)
#define SC_UPD1(P) asm volatile( \
        "v_fma_f32 %[s0], %[s0], %[w0], %[t0]\n\tv_fma_f32 %[s1], %[s1], %[w1], %[t1]\n\tv_fma_f32 %[s2], %[s2], %[w2], %[t2]\n\tv_fma_f32 %[s3], %[s3], %[w3], %[t3]\n\t" \
        "v_fma_f32 %[s4], %[s4], %[w4], %[t4]\n\tv_fma_f32 %[s5], %[s5], %[w5], %[t5]\n\tv_fma_f32 %[s6], %[s6], %[w6], %[t6]\n\tv_fma_f32 %[s7], %[s7], %[w7], %[t7]" \
        : [s0] "+v"(s0), [s1] "+v"(s1), [s2] "+v"(s2), [s3] "+v"(s3), [s4] "+v"(s4), [s5] "+v"(s5), [s6] "+v"(s6), [s7] "+v"(s7) \
        : [t0] "v"(t0), [t1] "v"(t1), [t2] "v"(t2), [t3] "v"(t3), [t4] "v"(t4), [t5] "v"(t5), [t6] "v"(t6), [t7] "v"(t7), \
          [w0] "v"(P##w0.x), [w1] "v"(P##w0.y), [w2] "v"(P##w0.z), [w3] "v"(P##w0.w), [w4] "v"(P##w1.x), [w5] "v"(P##w1.y), [w6] "v"(P##w1.z), [w7] "v"(P##w1.w))
#define SC_UPD2(P) asm volatile( \
        "v_fma_f32 %[s0], -%[d], %[a0], %[s0]\n\tv_fma_f32 %[s4], -%[d], %[a4], %[s4]\n\tv_fma_f32 %[s1], -%[d], %[a1], %[s1]\n\tv_fma_f32 %[s5], -%[d], %[a5], %[s5]\n\t" \
        "v_fma_f32 %[s2], -%[d], %[a2], %[s2]\n\tv_fma_f32 %[s6], -%[d], %[a6], %[s6]\n\tv_fma_f32 %[s3], -%[d], %[a3], %[s3]\n\tv_fma_f32 %[s7], -%[d], %[a7], %[s7]\n\t" \
        "v_mul_f32 %[y0], %[s0], %[r0]\n\tv_mul_f32 %[y1], %[s4], %[r4]\n\tv_fma_f32 %[y0], %[s1], %[r1], %[y0]\n\tv_fma_f32 %[y1], %[s5], %[r5], %[y1]\n\t" \
        "v_fma_f32 %[y0], %[s2], %[r2], %[y0]\n\tv_fma_f32 %[y1], %[s6], %[r6], %[y1]\n\tv_fma_f32 %[y0], %[s3], %[r3], %[y0]\n\tv_fma_f32 %[y1], %[s7], %[r7], %[y1]" \
        : [s0] "+v"(s0), [s1] "+v"(s1), [s2] "+v"(s2), [s3] "+v"(s3), [s4] "+v"(s4), [s5] "+v"(s5), [s6] "+v"(s6), [s7] "+v"(s7), [y0] "=&v"(y0), [y1] "=&v"(y1) \
        : [d] "v"(dA), [a0] "v"(P##ka0.x), [a1] "v"(P##ka0.y), [a2] "v"(P##ka0.z), [a3] "v"(P##ka0.w), [a4] "v"(P##ka1.x), [a5] "v"(P##ka1.y), [a6] "v"(P##ka1.z), [a7] "v"(P##ka1.w), \
          [r0] "v"(P##r0.x), [r1] "v"(P##r0.y), [r2] "v"(P##r0.z), [r3] "v"(P##r0.w), [r4] "v"(P##r1.x), [r5] "v"(P##r1.y), [r6] "v"(P##r1.z), [r7] "v"(P##r1.w))
#define SC_BODY(P) float dA, t0, t1, t2, t3, t4, t5, t6, t7, y0, y1, yA; \
        SC_RED1(P); SC_UPD1(P); SC_UPD2(P);
#define SC_STEP_M(P, N, t) do { SC_BODY(P) SC_RED2(N); *(LAS float*)(yb + (t) * 128) = yA; } while (0)
#define SC_STEP_L(P, t) do { SC_BODY(P) SC_RED2L(); *(LAS float*)(yb + (t) * 128) = yA; } while (0)
        f32x4 p0kk0, p0kk1, p0w0, p0w1, p0ka0, p0ka1, p0km0, p0km1, p0r0, p0r1, p1kk0, p1kk1, p1w0, p1w1, p1ka0, p1ka1, p1km0, p1km1, p1r0, p1r1; float p0v, p1v, m0, m1;
        SC_LD(p0, 0);
        SC_PART(p0);
#pragma unroll 2
        for (int t = 0; t < SC_T - 2; t += 2) {
            SC_LD(p1, t + 1);
            SC_STEP_M(p0, p1, t);
            SC_LD(p0, t + 2);
            SC_STEP_M(p1, p0, t + 1);
        }
        SC_LD(p1, SC_T - 1);
        SC_STEP_M(p0, p1, SC_T - 2);
        SC_STEP_L(p1, SC_T - 1);
        asm volatile("s_waitcnt lgkmcnt(0)" ::: "memory");
        if (lane < 32) { const int sy = lane >> 1, r4i = 8 * wave + 4 * (lane & 1);
            *(GAS f32x4*)(YR + (size_t)(b * SEQ + ck * SC_T + sy) * RW + h * 64 + half * 32 + r4i) = *(const LAS f32x4*)(lds + SC_YB + (ck & 1) * 2048 + sy * 128 + r4i * 4); }
        SC_WAIT();
        bcur = bnext;
    }
#undef SC_BAR
#undef SC_ARRIVE
#undef SC_WAIT
#undef SC_LOAD
#undef SC_UNP
#undef SC_STORE
#undef SC_LD
#undef SC_MUL
#undef SC_FMA
#undef SC_FNMA
#undef SC_RED1
#undef SC_RED2
#undef SC_RED2L
#undef SC_PART
#undef SC_BODY
#undef SC_UPD1
#undef SC_UPD2
#undef SC_STEP_M
#undef SC_STEP_L
    __builtin_amdgcn_s_setprio(0);
    }
    __syncthreads();
}

constexpr int FX_KP = 272, FX_VP = 320, FX_K0 = 0, FX_KB = 64 * FX_KP, FX_V0 = 2 * FX_KB, FX_VB = 64 * FX_VP, FX_C0 = FX_V0 + 2 * FX_VB, FX_CB = 256;
DI void fox_block(const bf16* PROJ, const float* Cb, bf16* MIX, int b, int h, int xq, LAS unsigned char* lds, int tid, int wave, int lane) {
    const int c = lane & 31, hh = lane >> 5, i16 = lane & 15, q4 = i16 >> 2, p4 = i16 & 3, blk = (lane >> 4) & 1;
    const int qbase = xq * 256 + 32 * wave, q_abs = qbase + c;
    const size_t rowq = (size_t)(b * SEQ + q_abs);
    bf16x8 qf[8];
#pragma unroll
    for (int ks = 0; ks < 8; ++ks) qf[ks] = *(const GAS bf16x8*)(PROJ + rowq * NIN + h * FOXD + 16 * ks + 8 * hh);
    const float cq2 = Cb[q_abs];
    f32x16 o[4];
#pragma unroll
    for (int d = 0; d < 4; ++d)
#pragma unroll
        for (int i = 0; i < 16; ++i) o[d][i] = 0.f;
    float mrun = -1e30f, lrun = 0.f;
    const int ntiles = 4 * (xq + 1);
    const int key0 = tid >> 4, c16 = tid & 15;
    const bf16* kg = PROJ + (size_t)(b * SEQ + key0) * NIN + 2048 + h * FOXD + 8 * c16;
    const int kl = key0 * FX_KP + c16 * 16, vl = key0 * FX_VP + c16 * 16;
    u32x4 kr0, kr1, vr0, vr1; float ckr = 0.f;
#define FX_LOAD(j) do { const bf16* _p = kg + (size_t)(j) * 64 * NIN; kr0 = *(const GAS u32x4*)_p; kr1 = *(const GAS u32x4*)(_p + (size_t)32 * NIN); vr0 = *(const GAS u32x4*)(_p + 2048); vr1 = *(const GAS u32x4*)(_p + (size_t)32 * NIN + 2048); \
        if (tid < 64) ckr = Cb[(j) * 64 + tid]; } while (0)
#define FX_STORE(bi) do { *(LAS u32x4*)(lds + FX_K0 + (bi) * FX_KB + kl) = kr0; *(LAS u32x4*)(lds + FX_K0 + (bi) * FX_KB + kl + 32 * FX_KP) = kr1; \
        *(LAS u32x4*)(lds + FX_V0 + (bi) * FX_VB + vl) = vr0; *(LAS u32x4*)(lds + FX_V0 + (bi) * FX_VB + vl + 32 * FX_VP) = vr1; if (tid < 64) *(LAS float*)(lds + FX_C0 + (bi) * FX_CB + tid * 4) = ckr; } while (0)
    FX_LOAD(0); FX_STORE(0);
    __syncthreads();
    const float C2S = 0.08838834764831845f * LOG2E;
    const int kbase = c * FX_KP + hh * 16, vbase = (4 * hh + q4) * FX_VP + blk * 32 + p4 * 8;
    for (int j = 0; j < ntiles; ++j) {
        const int bi = j & 1;
        if (j + 1 < ntiles) FX_LOAD(j + 1);
        if (64 * j <= qbase + 31) {
            const LAS unsigned char* KL = lds + FX_K0 + bi * FX_KB + kbase; const LAS unsigned char* VL = lds + FX_V0 + bi * FX_VB + vbase; const LAS unsigned char* CL = lds + FX_C0 + bi * FX_CB + hh * 16;
            f32x16 p0, p1;
#pragma unroll
            for (int i = 0; i < 16; ++i) { p0[i] = 0.f; p1[i] = 0.f; }
#pragma unroll
            for (int ks = 0; ks < 8; ++ks) { const bf16x8 a0 = *(const LAS bf16x8*)(KL + ks * 32), a1 = *(const LAS bf16x8*)(KL + 32 * FX_KP + ks * 32);
                p0 = __builtin_amdgcn_mfma_f32_32x32x16_bf16(a0, qf[ks], p0, 0, 0, 0); p1 = __builtin_amdgcn_mfma_f32_32x32x16_bf16(a1, qf[ks], p1, 0, 0, 0); }
#pragma unroll
            for (int gI = 0; gI < 4; ++gI) { const f32x4 c0 = *(const LAS f32x4*)(CL + gI * 32), c1 = *(const LAS f32x4*)(CL + 128 + gI * 32);
#pragma unroll
                for (int jj = 0; jj < 4; ++jj) { p0[4 * gI + jj] = fmaf(p0[4 * gI + jj], C2S, -c0[jj]); p1[4 * gI + jj] = fmaf(p1[4 * gI + jj], C2S, -c1[jj]); } }
            if (64 * j + 63 > qbase) {
                const float NEG = -__builtin_inff();
#pragma unroll
                for (int i = 0; i < 16; ++i) { const int key = 64 * j + (i & 3) + 8 * (i >> 2) + 4 * hh; if (key > q_abs) p0[i] = NEG; if (key + 32 > q_abs) p1[i] = NEG; }
            }
            float mt = fmaxf(p0[0], p1[0]);
#pragma unroll
            for (int i = 1; i < 16; ++i) mt = fmaxf(mt, fmaxf(p0[i], p1[i]));
            mt = fmaxf(mt, __shfl_xor(mt, 32));
            const float mn = fmaxf(mrun, mt), alpha = __builtin_amdgcn_exp2f(mrun - mn); mrun = mn;
            float ls = 0.f;
#pragma unroll
            for (int i = 0; i < 16; ++i) { p0[i] = __builtin_amdgcn_exp2f(p0[i] - mn); p1[i] = __builtin_amdgcn_exp2f(p1[i] - mn); ls += p0[i] + p1[i]; }
            lrun = lrun * alpha + ls;
#pragma unroll
            for (int d = 0; d < 4; ++d)
#pragma unroll
                for (int i = 0; i < 16; ++i) o[d][i] *= alpha;
            bf16x8 pf[2][2];
#pragma unroll
            for (int s = 0; s < 2; ++s) {
                u32x4 w0, w1; w0.x = pk2(p0[8 * s], p0[8 * s + 1]); w0.y = pk2(p0[8 * s + 2], p0[8 * s + 3]); w0.z = pk2(p0[8 * s + 4], p0[8 * s + 5]); w0.w = pk2(p0[8 * s + 6], p0[8 * s + 7]);
                w1.x = pk2(p1[8 * s], p1[8 * s + 1]); w1.y = pk2(p1[8 * s + 2], p1[8 * s + 3]); w1.z = pk2(p1[8 * s + 4], p1[8 * s + 5]); w1.w = pk2(p1[8 * s + 6], p1[8 * s + 7]);
                pf[0][s] = __builtin_bit_cast(bf16x8, w0); pf[1][s] = __builtin_bit_cast(bf16x8, w1); }
#pragma unroll
            for (int d = 0; d < 4; ++d)
#pragma unroll
                for (int kb = 0; kb < 2; ++kb)
#pragma unroll
                    for (int s = 0; s < 2; ++s) {
                        const s16x4 lo = __builtin_amdgcn_ds_read_tr16_b64_v4i16((LAS s16x4*)(VL + (32 * kb + 16 * s) * FX_VP + d * 64));
                        const s16x4 hi = __builtin_amdgcn_ds_read_tr16_b64_v4i16((LAS s16x4*)(VL + (32 * kb + 16 * s + 8) * FX_VP + d * 64));
                        const bf16x8 av = __builtin_shufflevector(lo, hi, 0, 1, 2, 3, 4, 5, 6, 7);
                        o[d] = __builtin_amdgcn_mfma_f32_32x32x16_bf16(av, pf[kb][s], o[d], 0, 0, 0); }
        }
        if (j + 1 < ntiles) FX_STORE(bi ^ 1);
        __syncthreads();
    }
#undef FX_LOAD
#undef FX_STORE
    const float ltot = lrun + __shfl_xor(lrun, 32); const float inv = 1.0f / ltot;
    bf16* orow = MIX + rowq * D + h * FOXD + 4 * hh;
#pragma unroll
    for (int d = 0; d < 4; ++d)
#pragma unroll
        for (int gI = 0; gI < 4; ++gI) { u32x2 w; w.x = pk2(o[d][4 * gI] * inv, o[d][4 * gI + 1] * inv); w.y = pk2(o[d][4 * gI + 2] * inv, o[d][4 * gI + 3] * inv);
            *(GAS u32x2*)(orow + 32 * d + 8 * gI) = w; }
}
DI void fox_phase(CArgs& a, LAS unsigned char* lds, int tid, int wave, int lane) {
    const bf16* PROJ = (const bf16*)(a.ws + WS_BIG); const float* C = (const float*)(a.ws + WS_C); bf16* MIX = (bf16*)(a.ws + WS_ACT2);
    for (int u = blockIdx.x; u < 256; u += gridDim.x) { const int bh = u >> 2, y = u & 3, b = bh >> 4, h = bh & 15;
        for (int s2 = 0; s2 < 2; ++s2) fox_block(PROJ, C + (size_t)bh * SEQ, MIX, b, h, s2 ? y : 7 - y, lds, tid, wave, lane); }
}

constexpr int F4_B = SC_CVT, F4_VP = 304, F4_K = F4_B, F4_V = F4_K + 64 * FX_KP, F4_C = F4_V + 64 * F4_VP, F4_Q = F4_C + 256, F4_QW = 32 * FX_KP;
static_assert(F4_Q + 4 * F4_QW <= MISC_OFF, "fox4 LDS map");
constexpr float FOX_THR = 16.0f;
DI void fox4_tile(const LAS unsigned char* KL, const LAS unsigned char* VL, const LAS unsigned char* CL, const LAS unsigned char* QL, int j, int qbase, int q_abs, int hh, float cq2, f32x16 (&o)[4], float& mrun, float& lrun) {
    const float C2S = 0.08838834764831845f * LOG2E;
    f32x16 p0, p1;
#pragma unroll
    for (int i = 0; i < 16; ++i) { p0[i] = 0.f; p1[i] = 0.f; }
#pragma unroll
    for (int ks = 0; ks < 8; ++ks) { const bf16x8 a0 = *(const LAS bf16x8*)(KL + ks * 32), a1 = *(const LAS bf16x8*)(KL + 32 * FX_KP + ks * 32), qk = *(const LAS bf16x8*)(QL + ks * 32);
        p0 = __builtin_amdgcn_mfma_f32_32x32x16_bf16(a0, qk, p0, 0, 0, 0); p1 = __builtin_amdgcn_mfma_f32_32x32x16_bf16(a1, qk, p1, 0, 0, 0); }
#pragma unroll
    for (int gI = 0; gI < 4; ++gI) { const f32x4 c0 = *(const LAS f32x4*)(CL + gI * 32), c1 = *(const LAS f32x4*)(CL + 128 + gI * 32);
#pragma unroll
        for (int jj = 0; jj < 4; ++jj) { p0[4 * gI + jj] = fmaf(p0[4 * gI + jj], C2S, -c0[jj]); p1[4 * gI + jj] = fmaf(p1[4 * gI + jj], C2S, -c1[jj]); } }
    if (64 * j + 63 > qbase) {
        const float NEG = -__builtin_inff();
#pragma unroll
        for (int i = 0; i < 16; ++i) { const int key = 64 * j + (i & 3) + 8 * (i >> 2) + 4 * hh; if (key > q_abs) p0[i] = NEG; if (key + 32 > q_abs) p1[i] = NEG; }
    }
    float mt = fmaxf(p0[0], p1[0]);
#pragma unroll
    for (int i = 1; i < 16; ++i) mt = fmaxf(mt, fmaxf(p0[i], p1[i]));
    mt = fmaxf(mt, __shfl_xor(mt, 32));
    const bool need = mt > mrun + FOX_THR;
    if (__builtin_amdgcn_ballot_w64(need)) {
        const float mn = need ? mt : mrun, alpha = __builtin_amdgcn_exp2f(mrun - mn); mrun = mn; lrun *= alpha;
#pragma unroll
        for (int d = 0; d < 4; ++d)
#pragma unroll
            for (int i = 0; i < 16; ++i) o[d][i] *= alpha;
    }
    const float mn = mrun;
    float ls = 0.f;
#pragma unroll
    for (int i = 0; i < 16; ++i) { p0[i] = __builtin_amdgcn_exp2f(p0[i] - mn); p1[i] = __builtin_amdgcn_exp2f(p1[i] - mn); ls += p0[i] + p1[i]; }
    lrun += ls;
    bf16x8 pf[2][2];
#pragma unroll
    for (int s = 0; s < 2; ++s) {
        u32x4 w0, w1; w0.x = pk2(p0[8 * s], p0[8 * s + 1]); w0.y = pk2(p0[8 * s + 2], p0[8 * s + 3]); w0.z = pk2(p0[8 * s + 4], p0[8 * s + 5]); w0.w = pk2(p0[8 * s + 6], p0[8 * s + 7]);
        w1.x = pk2(p1[8 * s], p1[8 * s + 1]); w1.y = pk2(p1[8 * s + 2], p1[8 * s + 3]); w1.z = pk2(p1[8 * s + 4], p1[8 * s + 5]); w1.w = pk2(p1[8 * s + 6], p1[8 * s + 7]);
        pf[0][s] = __builtin_bit_cast(bf16x8, w0); pf[1][s] = __builtin_bit_cast(bf16x8, w1); }
#pragma unroll
    for (int d = 0; d < 4; ++d)
#pragma unroll
        for (int kb = 0; kb < 2; ++kb)
#pragma unroll
            for (int s = 0; s < 2; ++s) {
                const s16x4 lo = __builtin_amdgcn_ds_read_tr16_b64_v4i16((LAS s16x4*)(VL + (32 * kb + 16 * s) * F4_VP + d * 64));
                const s16x4 hi = __builtin_amdgcn_ds_read_tr16_b64_v4i16((LAS s16x4*)(VL + (32 * kb + 16 * s + 8) * F4_VP + d * 64));
                const bf16x8 av = __builtin_shufflevector(lo, hi, 0, 1, 2, 3, 4, 5, 6, 7);
                o[d] = __builtin_amdgcn_mfma_f32_32x32x16_bf16(av, pf[kb][s], o[d], 0, 0, 0); }
}
DI void fox4_run(CArgs& a, int u, LAS unsigned char* lds, volatile LAS unsigned* cnt, unsigned& target, int w4, int lane) {
    const bf16* PROJ = (const bf16*)(a.ws + WS_BIG); bf16* MIX = (bf16*)(a.ws + WS_ACT2);
    const int bh = u >> 2, y = u & 3, b = bh >> 4, h = bh & 15; const float* Cb = (const float*)(a.ws + WS_C) + (size_t)bh * SEQ;
    const int t4 = w4 * 64 + lane;
#define F4_BAR() do { asm volatile("s_waitcnt lgkmcnt(0)" ::: "memory"); if (lane == 0) __hip_atomic_fetch_add((LAS unsigned*)cnt, 1u, __ATOMIC_RELAXED, __HIP_MEMORY_SCOPE_WORKGROUP); target += 4u; \
        while ((int)(__hip_atomic_load((LAS unsigned*)cnt, __ATOMIC_RELAXED, __HIP_MEMORY_SCOPE_WORKGROUP) - target) < 0) { } asm volatile("" ::: "memory"); } while (0)
    const int c = lane & 31, hh = lane >> 5, i16 = lane & 15, q4 = i16 >> 2, p4 = i16 & 3, blk = (lane >> 4) & 1;
    const int key0 = t4 >> 4, c16 = t4 & 15;
    const unsigned koff = (unsigned)(key0 * NIN + 8 * c16) * 2u;
    const int kl = key0 * FX_KP + c16 * 16, vl = key0 * F4_VP + c16 * 16;
    const int kbase = c * FX_KP + hh * 16, vbase = (4 * hh + q4) * F4_VP + blk * 32 + p4 * 8;
    LAS unsigned char* QLw = lds + F4_Q + w4 * F4_QW + c * FX_KP + hh * 16;
    F4_BAR();
#pragma unroll 1
    for (int bi = 0; bi < 4; ++bi) {
        const int xq = (bi == 0) ? 15 - y : (bi == 1) ? 8 + y : (bi == 2) ? 7 - y : y;
        const int qbase = xq * 128 + 32 * w4, q_abs = qbase + c; const size_t rowq = (size_t)(b * SEQ + q_abs);
#pragma unroll
        for (int ks = 0; ks < 8; ++ks) *(LAS bf16x8*)(QLw + ks * 32) = *(const GAS bf16x8*)(PROJ + rowq * NIN + h * FOXD + 16 * ks + 8 * hh);
        const float cq2 = Cb[q_abs];
        f32x16 o[4];
#pragma unroll
        for (int d = 0; d < 4; ++d)
#pragma unroll
            for (int i = 0; i < 16; ++i) o[d][i] = 0.f;
        float mrun = -1e30f, lrun = 0.f;
        const int ntiles = 2 * (xq + 1);
        u32x4 kr[4], vr[4]; float ckr = 0.f;
#define F4_LOAD(j) do { const char* _b = (const char*)PROJ + ((size_t)(b * SEQ + (j) * 64) * NIN + 2048 + h * FOXD) * 2; \
        _Pragma("unroll") for (int _i = 0; _i < 4; ++_i) { kr[_i] = *(const GAS u32x4*)(_b + (size_t)(16 * _i) * NIN * 2 + koff); vr[_i] = *(const GAS u32x4*)(_b + (size_t)(16 * _i) * NIN * 2 + 4096 + koff); } \
        if (t4 < 64) ckr = Cb[(j) * 64 + t4]; } while (0)
#define F4_STORE() do { _Pragma("unroll") for (int _i = 0; _i < 4; ++_i) { *(LAS u32x4*)(lds + F4_K + kl + 16 * _i * FX_KP) = kr[_i]; *(LAS u32x4*)(lds + F4_V + vl + 16 * _i * F4_VP) = vr[_i]; } \
        if (t4 < 64) *(LAS float*)(lds + F4_C + t4 * 4) = ckr; } while (0)
        F4_LOAD(0); F4_STORE();
        F4_BAR();
        for (int j = 0; j < ntiles; ++j) {
            if (j + 1 < ntiles) F4_LOAD(j + 1);
            if (64 * j <= qbase + 31) fox4_tile(lds + F4_K + kbase, lds + F4_V + vbase, lds + F4_C + hh * 16, QLw, j, qbase, q_abs, hh, cq2, o, mrun, lrun);
            F4_BAR();
            if (j + 1 < ntiles) F4_STORE();
            F4_BAR();
        }
#undef F4_LOAD
#undef F4_STORE
        const float ltot = lrun + __shfl_xor(lrun, 32); const float inv = 1.0f / ltot;
        bf16* orow = MIX + rowq * D + h * FOXD + 4 * hh;
#pragma unroll
        for (int d = 0; d < 4; ++d)
#pragma unroll
            for (int gI = 0; gI < 4; ++gI) { u32x2 w; w.x = pk2(o[d][4 * gI] * inv, o[d][4 * gI + 1] * inv); w.y = pk2(o[d][4 * gI + 2] * inv, o[d][4 * gI + 3] * inv);
                *(GAS u32x2*)(orow + 32 * d + 8 * gI) = w; }
    }
#undef F4_BAR
}

#ifndef MK_ONE_LAUNCH
#define MK_ONE_LAUNCH 1
#endif

constexpr int N_PHASES = 19;
#ifndef PROBE_REPS
#define PROBE_REPS {1,1,1,1,1, 1,1,1,1,1, 1,1,1,1,1, 1,1,1,1}
#endif
constexpr int REPS_[N_PHASES] = PROBE_REPS;
__global__ void __launch_bounds__(NTHR, 2) fwd(Args args_) {
    CArgs* argp_ = (CArgs*)__builtin_amdgcn_kernarg_segment_ptr(); asm volatile("" : "+s"(argp_)); CArgs& args = *argp_; (void)args_;
    extern __shared__ __attribute__((aligned(16))) unsigned char smem[];
    LAS unsigned char* lds = (LAS unsigned char*)smem;
    const int wave = __builtin_amdgcn_readfirstlane((int)threadIdx.x >> 6);
#define lane lane_id()
#define tid (wave * 64 + lane_id())
    const int G = gridDim.x, cid = blockIdx.x;
    volatile LAS unsigned* MISC = (volatile LAS unsigned*)(lds + MISC_OFF);
    for (int u = threadIdx.x; u < (LDS_BYTES - MISC_OFF) / 4; u += NTHR) MISC[u] = 0u;
    __syncthreads();
    const int lo = args.ph_lo, hi = args.ph_hi;
    unsigned* barw = (unsigned*)(args.ws + WS_CTL) + CW_BAR;
    XcdBarrier bar; bar.bar = barw; bar.x = 0; bar.st = MISC; bar.wave = wave;
    if (hi - lo > 1) bar = xcd_barrier_post(barw, MISC, wave);
#define IN(k) (lo <= (k) && (k) < hi)
#define SEAM(k) do { if (IN(k) && IN((k) + 1)) xcd_barrier(bar); } while (0)
    unsigned char* ws = args.ws;
    bf16* H = (bf16*)(ws + WS_H); bf16* U = (bf16*)(ws + WS_BIG); bf16* PROJ = (bf16*)(ws + WS_BIG); bf16* ACT2 = (bf16*)(ws + WS_ACT2);
    bf16* X = (bf16*)(ws + WS_X);
    bf16* Yb = (bf16*)(ws + WS_Y + 64 * MiB);
    const pg8::BatchOff Z0{0, 0, 1};

    if (IN(0)) { _Pragma("unroll") for (int rep_ = 0; rep_ < REPS_[0]; ++rep_) { if (rep_) xcd_barrier(bar); p0_prologue(args, lds, wave, lane); } SEAM(0); }
    if (IN(1)) { _Pragma("unroll") for (int rep_ = 0; rep_ < REPS_[1]; ++rep_) { if (rep_) xcd_barrier(bar);
        pg8::Gemm g{H, (const bf16*)(ws + WS_F1GU), D, D, D, Z0, Z0}; pg8::StaticOrder S; S.init(M, NGU, 1, G, cid);
        pg8::EpiSwiGLU E{U, FF, 1.0f};
        if (G == 256) {
            const int nall_full = S.nall; S.nall = 10 * 256;
            pg8::gemm_phase<pg8::EpiSwiGLU>(lds, g, S, E, wave);
            if (wave == 0 && lane == 0) MISC[24] = atomicAdd((unsigned*)(ws + WS_P1CTR), 1u);
            __syncthreads();
            const unsigned k11 = MISC[24];
            if (k11 < 192u) { pg8::StaticOrder S2 = S; S2.nall = nall_full; S2.G = nall_full; S2.c = 10 * 256 + (int)k11; pg8::gemm_phase<pg8::EpiSwiGLU>(lds, g, S2, E, wave); }
            else tail_cvt(args, lds, wave, lane, CVT_EARLY, CVT_TAIL - 1024, (int)k11 - 192, 64);
        } else pg8::gemm_phase<pg8::EpiSwiGLU>(lds, g, S, E, wave);
        } SEAM(1); }
    if (IN(2)) { _Pragma("unroll") for (int rep_ = 0; rep_ < REPS_[2]; ++rep_) { if (rep_) xcd_barrier(bar);
        pg8::Gemm g{U, (const bf16*)(ws + WS_F1D), FF, FF, FF, Z0, Z0}; pg8::StaticOrder S; S.init(M, D, 1, G, cid);
        pg8::EpiBf16 E{Yb, D, Z0, -1, nullptr}; pg8::gemm_phase<pg8::EpiBf16>(lds, g, S, E, wave); } SEAM(2); }
    if (IN(3)) { _Pragma("unroll") for (int rep_ = 0; rep_ < REPS_[3]; ++rep_) { if (rep_) xcd_barrier(bar); seam_phase<false, true, false>(args.in[I_X], Yb, X, H, args.in[I_F1POST], args.in[I_MIXPRE], 0.5f, wave, lane, (float*)(ws + WS_RSTD)); } SEAM(3); }
    if (IN(4)) { _Pragma("unroll") for (int rep_ = 0; rep_ < REPS_[4]; ++rep_) { if (rep_) xcd_barrier(bar);
        { pg8::Gemm g{X, (const bf16*)(ws + WS_W_IN), D, D, D, Z0, Z0}; pg8::StaticOrder S; S.init(M, NIN, 1, G, cid);
          pg8::EpiBf16R E{PROJ, NIN, 49, (float*)(ws + WS_FL), (const float*)(ws + WS_RSTD)}; pg8::gemm_phase<pg8::EpiBf16R>(lds, g, S, E, wave); }
        { pg8::Gemm g{(const bf16*)(ws + WS_MEMN), (const bf16*)(ws + WS_WK), D, D, D, Z0, Z0}; pg8::StaticOrder S; S.init(MM, D, 1, G, (cid + G - 64 % G) % G);
          pg8::EpiBf16 E{(bf16*)(ws + WS_KMEM), D, Z0, -1, nullptr}; pg8::gemm_phase<pg8::EpiBf16>(lds, g, S, E, wave); }
        { pg8::Gemm g{(const bf16*)(ws + WS_WV), (const bf16*)(ws + WS_MEMN), D, D, D, Z0, Z0}; pg8::StaticOrder S; S.init(D, MM, 1, G, (cid + G - 128 % G) % G);
          pg8::EpiBf16 E{(bf16*)(ws + WS_VT), MM, Z0, -1, nullptr}; pg8::gemm_phase<pg8::EpiBf16>(lds, g, S, E, wave); }
        if (G == 256 && cid >= 192) tail_cvt(args, lds, wave, lane, CVT_EARLY + CVT_TAIL - 1024, CVT_TAIL + 1024, cid - 192, 64);
        } SEAM(4); }
    if (IN(5)) { _Pragma("unroll") for (int rep_ = 0; rep_ < REPS_[5]; ++rep_) { if (rep_) xcd_barrier(bar); fox_cumsum_phase(args, lds, wave, lane); lora_act_phase(args, wave, lane); } SEAM(5); }
    if (IN(6)) { _Pragma("unroll") for (int rep_ = 0; rep_ < REPS_[6]; ++rep_) { if (rep_) xcd_barrier(bar);
        { pg8::Gemm g{(const bf16*)(ws + WS_ALORA), (const bf16*)(ws + WS_LORAW), ALD, LORA_K, LORA_K, Z0, Z0}; pg8::StaticOrder S; S.init(M, RW, 1, G, cid);
          pg8::EpiLora<0> E{args.in[I_W0], (float*)(ws + WS_WDEC), nullptr}; pg8::gemm_phase<pg8::EpiLora<0>>(lds, g, S, E, wave); }
        { pg8::Gemm g{(const bf16*)(ws + WS_ALORA) + LORA_K, (const bf16*)(ws + WS_LORAW) + (size_t)RW * LORA_K, ALD, LORA_K, LORA_K, Z0, Z0}; pg8::StaticOrder S; S.init(M, RW, 1, G, cid);
          pg8::EpiLora<1> E{args.in[I_A0], (float*)(ws + WS_AA), nullptr}; pg8::gemm_phase<pg8::EpiLora<1>>(lds, g, S, E, wave); }
        { pg8::Gemm g{(const bf16*)(ws + WS_ALORA) + 2 * LORA_K, (const bf16*)(ws + WS_LORAW) + (size_t)2 * RW * LORA_K, ALD, LORA_K, LORA_K, Z0, Z0}; pg8::StaticOrder S; S.init(M, RW, 1, G, cid);
          pg8::EpiLora<2> E{nullptr, nullptr, (bf16*)(ws + WS_G)}; pg8::gemm_phase<pg8::EpiLora<2>>(lds, g, S, E, wave); }
        } SEAM(6); }
    if (IN(7)) { _Pragma("unroll") for (int rep_ = 0; rep_ < REPS_[7]; ++rep_) { if (rep_) xcd_barrier(bar); for (int u = cid; u < 256; u += G) scan_unit(args, u, u == cid, lds, MISC + 4, tid, wave, lane); } SEAM(7); }
    if (IN(8)) { _Pragma("unroll") for (int rep_ = 0; rep_ < REPS_[8]; ++rep_) { if (rep_) xcd_barrier(bar); rwkv_post_phase(args, wave, lane); } SEAM(8); }
    if (IN(9)) { _Pragma("unroll") for (int rep_ = 0; rep_ < REPS_[9]; ++rep_) { if (rep_) xcd_barrier(bar);
        pg8::Gemm g{ACT2, (const bf16*)(ws + WS_W_OUT), D, D, D, Z0, Z0}; pg8::StaticOrder S; S.init(M, D, 1, G, cid);
        pg8::EpiBf16 E{Yb, D, Z0, -1, nullptr}; pg8::gemm_phase<pg8::EpiBf16>(lds, g, S, E, wave); } SEAM(9); }
    if (IN(10)) { _Pragma("unroll") for (int rep_ = 0; rep_ < REPS_[10]; ++rep_) { if (rep_) xcd_barrier(bar); seam_phase<false, false, false>(X, Yb, X, H, args.in[I_MIXPOST], args.in[I_XPRE], 1.0f, wave, lane, (float*)(ws + WS_RSTD)); } SEAM(10); }
    if (IN(11)) { _Pragma("unroll") for (int rep_ = 0; rep_ < REPS_[11]; ++rep_) { if (rep_) xcd_barrier(bar);
        pg8::Gemm g{X, (const bf16*)(ws + WS_WQ), D, D, D, Z0, Z0}; pg8::StaticOrder S; S.init(M, D, 1, G, cid);
        pg8::EpiBf16R E{ACT2, D, -1, nullptr, (const float*)(ws + WS_RSTD)}; pg8::gemm_phase<pg8::EpiBf16R>(lds, g, S, E, wave); } SEAM(11); }
    if (IN(12)) { _Pragma("unroll") for (int rep_ = 0; rep_ < REPS_[12]; ++rep_) { if (rep_) xcd_barrier(bar);
        pg8::Gemm g{ACT2, (const bf16*)(ws + WS_KMEM), D, D, 1024, pg8::BatchOff{(long)SEQ * D, 1024, 4}, pg8::BatchOff{(long)NMEM * D, 1024, 4}}; pg8::StaticOrder S; S.init(SEQ, NMEM, 16, G, cid);
        pg8::EpiSoftmax E{(bf16*)(ws + WS_BIG), 0.03125f * LOG2E}; pg8::gemm_phase<pg8::EpiSoftmax, false>(lds, g, S, E, wave); } SEAM(12); }
    if (IN(13)) { _Pragma("unroll") for (int rep_ = 0; rep_ < REPS_[13]; ++rep_) { if (rep_) xcd_barrier(bar);
        pg8::Gemm g{(const bf16*)(ws + WS_BIG), (const bf16*)(ws + WS_VT), NMEM, MM, NMEM, pg8::BatchOff{(long)SEQ * NMEM, 0, 1}, pg8::BatchOff{NMEM, (long)1024 * MM, 4}}; pg8::StaticOrder S; S.init(SEQ, 1024, 16, G, cid);
        pg8::EpiBf16 E{ACT2, D, pg8::BatchOff{(long)SEQ * D, 1024, 4}, -1, nullptr}; pg8::gemm_phase<pg8::EpiBf16>(lds, g, S, E, wave); } SEAM(13); }
    if (IN(14)) { _Pragma("unroll") for (int rep_ = 0; rep_ < REPS_[14]; ++rep_) { if (rep_) xcd_barrier(bar);
        pg8::Gemm g{ACT2, (const bf16*)(ws + WS_WO), D, D, D, Z0, Z0}; pg8::StaticOrder S; S.init(M, D, 1, G, cid);
        pg8::EpiBf16 E{Yb, D, Z0, -1, nullptr}; pg8::gemm_phase<pg8::EpiBf16>(lds, g, S, E, wave); } SEAM(14); }
    if (IN(15)) { _Pragma("unroll") for (int rep_ = 0; rep_ < REPS_[15]; ++rep_) { if (rep_) xcd_barrier(bar); seam_phase<true, false, false>(X, Yb, X, H, args.in[I_XPOST], args.in[I_F2PRE], 1.0f, wave, lane); } SEAM(15); }
    if (IN(16)) { _Pragma("unroll") for (int rep_ = 0; rep_ < REPS_[16]; ++rep_) { if (rep_) xcd_barrier(bar);
        pg8::Gemm g{H, (const bf16*)(ws + WS_F2GU), D / 2, D / 2, D / 2, Z0, Z0}; pg8::StaticOrder S; S.init(M, NGU, 1, G, cid);
        pg8::EpiSwiGLU8 E{(unsigned char*)U, FF, 1.0f / 512.0f};
        if (G == 256) {
            const int nall_full = S.nall; S.nall = 10 * 256;
            pg8::gemm_phase<pg8::EpiSwiGLU8, true, true, true>(lds, g, S, E, wave);
            if (wave == 0 && lane == 0) MISC[25] = atomicAdd((unsigned*)(ws + WS_P1CTR) + 16, 1u);
            __syncthreads();
            const unsigned k11 = MISC[25];
            if (k11 < 192u) { pg8::StaticOrder S2 = S; S2.nall = nall_full; S2.G = nall_full; S2.c = 10 * 256 + (int)k11; pg8::gemm_phase<pg8::EpiSwiGLU8, true, true, true>(lds, g, S2, E, wave); }
        } else pg8::gemm_phase<pg8::EpiSwiGLU8, true, true, true>(lds, g, S, E, wave);
        } SEAM(16); }
    if (IN(17)) { _Pragma("unroll") for (int rep_ = 0; rep_ < REPS_[17]; ++rep_) { if (rep_) xcd_barrier(bar);
        pg8::Gemm g{U, (const bf16*)(ws + WS_F2D), FF / 2, FF / 2, FF / 2, Z0, Z0}; pg8::StaticOrder S; S.init(M, D, 1, G, cid);
        pg8::EpiBf16S E{Yb, D, 1.0f / 1024.0f}; pg8::gemm_phase<pg8::EpiBf16S, true, true, true>(lds, g, S, E, wave); } SEAM(17); }
    if (IN(18)) { _Pragma("unroll") for (int rep_ = 0; rep_ < REPS_[18]; ++rep_) { if (rep_) xcd_barrier(bar); seam_phase<false, false, true>(X, Yb, args.out, nullptr, args.in[I_F2POST], nullptr, 0.5f, wave, lane); } }
#undef IN
#undef SEAM
#undef lane
#undef tid
}

extern "C" void kernel_launch(void* const* d_in, const int* in_sizes, int n_in, void* d_out, int out_size, void* d_ws, size_t ws_size, hipStream_t stream) {
    static int grid = 0;
    if (grid == 0) {
        if (n_in != 35 || in_sizes[0] != M * D || out_size != M * D || ws_size < WS_END) { fprintf(stderr, "kernel_launch: unexpected shapes (n_in %d, in0 %d, out %d, ws %zu < %zu)\n", n_in, n_in > 0 ? in_sizes[0] : -1, out_size, ws_size, (size_t)WS_END); grid = -1; return; }
        int dev = 0, cus = 0;
        if (hipGetDevice(&dev) != hipSuccess || hipDeviceGetAttribute(&cus, hipDeviceAttributeMultiprocessorCount, dev) != hipSuccess) { grid = -1; return; }
        if (hipFuncSetAttribute((const void*)fwd, hipFuncAttributeMaxDynamicSharedMemorySize, LDS_BYTES) != hipSuccess) { fprintf(stderr, "kernel_launch: hipFuncSetAttribute failed\n"); grid = -1; return; }
        int per_cu = 0;
        if (hipOccupancyMaxActiveBlocksPerMultiprocessor(&per_cu, (const void*)fwd, NTHR, LDS_BYTES) != hipSuccess || per_cu < 1) { fprintf(stderr, "kernel_launch: occupancy query says %d\n", per_cu); (void)hipGetLastError(); }
        grid = cus;
    }
    if (grid < 0) return;
    (void)hipMemsetAsync((char*)d_ws + WS_CTL, 0, CTL_ZERO_BYTES, stream);
    Args a{};
    for (int i = 0; i < 35; ++i) a.in[i] = (const float*)d_in[i];
    a.out = (float*)d_out; a.ws = (unsigned char*)d_ws;
#if MK_ONE_LAUNCH
    a.ph_lo = 0; a.ph_hi = N_PHASES;
    hipLaunchKernelGGL(fwd, dim3(grid), dim3(NTHR), LDS_BYTES, stream, a);
#else
    for (int p = MK_PH_BEG; p < MK_PH_END; ++p) { a.ph_lo = p; a.ph_hi = p + 1; hipLaunchKernelGGL(fwd, dim3(grid), dim3(NTHR), LDS_BYTES, stream, a); }
#endif
}
```

```cpp
#include <hip/hip_runtime.h>
#include <cstdio>
#include <cstdint>

#ifndef FOX_PRIO
#define FOX_PRIO 0
#endif
#define MK_PH_BEG 0
#define MK_PH_END 19
#define P0_PARTS 7
#define CVT_LO 0
#define CVT_HI CVT_EARLY
#define GAS __attribute__((address_space(1)))
#define LAS __attribute__((address_space(3)))
#define DI __device__ __forceinline__
typedef unsigned short bf16;
typedef short bf16x8 __attribute__((ext_vector_type(8)));
typedef short s16x4 __attribute__((ext_vector_type(4)));
typedef float f32x2 __attribute__((ext_vector_type(2)));
typedef float f32x4 __attribute__((ext_vector_type(4)));
typedef float f32x16 __attribute__((ext_vector_type(16)));
typedef unsigned u32x2 __attribute__((ext_vector_type(2)));
typedef unsigned u32x4 __attribute__((ext_vector_type(4)));
typedef __bf16 bf16x2_t __attribute__((ext_vector_type(2)));

DI int lane_id() { int l; asm volatile("v_mbcnt_lo_u32_b32 %0, -1, 0\n\tv_mbcnt_hi_u32_b32 %0, -1, %0" : "=v"(l)); return l; }
DI unsigned pk2(float lo, float hi) { f32x2 f = {lo, hi}; return __builtin_bit_cast(unsigned, __builtin_convertvector(f, bf16x2_t)); }
DI float bflo(unsigned u) { return __uint_as_float(u << 16); }
DI float bfhi(unsigned u) { return __uint_as_float(u & 0xffff0000u); }
DI float bf2f(bf16 b) { return __uint_as_float((unsigned)b << 16); }

constexpr int BATCH = 4, SEQ = 2048, M = BATCH * SEQ, D = 4096, FF = 11008, NGU = 2 * FF;
constexpr int NMEM = 256, MM = BATCH * NMEM;
constexpr int FOXH = 16, FOXD = 128, RH = 32, RD = 64, RW = 2048;
constexpr int IN_COLS = 12752, NIN = 12800;
constexpr int PC_RKV = 6144, PC_LORA = 12288, PC_FL = 12736;
constexpr int LORA_K = 256, ALD = 3 * LORA_K;
constexpr float RMS_EPS = 1e-6f, GN_EPS = 64e-5f, LOG2E = 1.4426950408889634f;

constexpr size_t MiB = 1u << 20;
constexpr size_t WS_CTL = 0, CTL_ZERO_BYTES = 1 * MiB;
constexpr size_t WS_P1CTR = WS_CTL + 900 * 1024;
constexpr size_t WS_RSTD = WS_CTL + 512 * 1024;
constexpr size_t WS_C = 1 * MiB;
constexpr size_t WS_FL = WS_C + 512 * 1024;
constexpr size_t WS_BON = 2 * MiB;
constexpr size_t WS_LORAW = 3 * MiB;
constexpr size_t WS_MEMN = 8 * MiB;
constexpr size_t WS_KMEM = 16 * MiB;
constexpr size_t WS_VT = 24 * MiB;
constexpr size_t WS_W_IN = 32 * MiB;
constexpr size_t WS_W_OUT = 132 * MiB, WS_WQ = 164 * MiB, WS_WO = 196 * MiB, WS_WK = 228 * MiB, WS_WV = 260 * MiB;
constexpr size_t WS_F1GU = 292 * MiB, WS_F1D = 464 * MiB, WS_F2GU = 550 * MiB, WS_F2D = 722 * MiB;
constexpr size_t WS_X = 808 * MiB;
constexpr size_t WS_Y = 936 * MiB;
constexpr size_t WS_WDEC = WS_Y, WS_AA = WS_Y + 64 * MiB;
constexpr size_t WS_H = 1064 * MiB;
constexpr size_t WS_YR = WS_H;
constexpr size_t WS_ACT2 = 1128 * MiB;
constexpr size_t WS_BIG = 1192 * MiB;
constexpr size_t WS_RR = 1392 * MiB, WS_RKM = 1424 * MiB, WS_RV = 1456 * MiB, WS_RKK = 1488 * MiB, WS_RKKA = 1520 * MiB;
constexpr size_t WS_G = 1552 * MiB;
constexpr size_t WS_ALORA = 1584 * MiB;
constexpr size_t WS_END = 1596 * MiB;

namespace pg8 {
typedef unsigned short bf16_t;
constexpr int BM = 256, BK = 64, HALF = 128, HTB = HALF * BK * 2, STAGE_BYTES = 8 * HTB, NXCD = 8, WGM = 8;
__host__ __device__ __forceinline__ int lds_byte(int r, int c) { const int st = (r >> 4) * 2 + (c >> 5), rr = r & 15, cc = c & 31, ob = rr * 64 + cc * 2; return st * 1024 + (ob ^ (((ob >> 9) & 1) << 5)); }
__host__ __device__ __forceinline__ void stage_rc(int b, int& R, int& C) { const int st = b / 1024, sb = b % 1024, swz = sb ^ (((sb >> 9) & 1) << 5); R = (st >> 1) * 16 + swz / 64; C = (st & 1) * 32 + (swz % 64) / 2; }
__host__ __device__ __forceinline__ int perm32(int rho) { const int n = rho >> 4, i = rho & 15; return 8 * (i >> 2) + 4 * n + (i & 3); }

struct Unit { int pm, pn, z; };
struct BatchOff { long hi, lo; int div; DI long off(int z) const { return (long)(z / div) * hi + (long)(z % div) * lo; } };
struct Gemm { const bf16_t* A; const bf16_t* Bt; int lda, ldb, K; BatchOff za, zb; };

struct StaticOrder {
    int nM, nN, nwg, nall, G, c;
    DI void init(int Mr, int Nc, int nz, int G_, int c_) { nM = Mr / BM; nN = Nc / BM; nwg = nM * nN; nall = nwg * nz; G = G_; c = c_; }
    DI bool next(int i, Unit& u) const {
        const long L = (long)i * G + c; if (L >= nall) return false;
        const int z = (int)(L / nwg); int wgid = (int)(L - (long)z * nwg);
        { const int q = nwg / NXCD, r = nwg % NXCD, xcd = wgid % NXCD, off = wgid / NXCD; wgid = (xcd < r ? xcd * (q + 1) : r * (q + 1) + (xcd - r) * q) + off; }
        const int nig = WGM * nN, gid = wgid / nig, fm = gid * WGM, gsz = (nM - fm) < WGM ? (nM - fm) : WGM;
        u.pm = fm + ((wgid % nig) % gsz); u.pn = (wgid % nig) / gsz; u.z = z; return true;
    }
};

typedef int i32x4 __attribute__((ext_vector_type(4)));
typedef int i32x8 __attribute__((ext_vector_type(8)));
template <class Epi, bool ALIGN_EPI = true, bool SP2 = true, bool F8 = false>
DI void gemm_phase(LAS unsigned char* lds, const Gemm g, const StaticOrder& S, const Epi& E, const int wid) {
    const int lane = lane_id(), tid = wid * 64 + lane, wr = wid >> 2, wc = wid & 3, fr = lane & 15, fq = lane >> 4;
    const int K = g.K, nt = K / BK;
    unsigned voff_A, voff_B;
    { int R, C; stage_rc(tid * 16, R, C); const int Rb = Epi::PERM ? ((R & ~31) + perm32(R & 31)) : R; voff_A = (unsigned)(R * g.lda + C) * 2u; voff_B = (unsigned)(Rb * g.ldb + C) * 2u; }
    const size_t r64A = (size_t)64 * g.lda * 2, r64B = (size_t)64 * g.ldb * 2;
    const size_t kstep = (size_t)(BK * 2);
    const size_t hstepA = (size_t)HALF * g.lda * 2, hstepB = (size_t)HALF * g.ldb * 2;
    const size_t tstepA = 2 * hstepA, tstepB = 2 * hstepB;
    const unsigned ldsw = (unsigned)wid * 1024u;
    const int aoff = lds_byte(wr * 64 + fr, fq * 8), boff = lds_byte(wc * 32 + fr, fq * 8);
#define PG8_SA(b, h) (((b) * 2 + (h)) * HTB)
#define PG8_SB(b, h) ((4 + (b) * 2 + (h)) * HTB)
#define PG8_STAGE(bufoff, gbase, voff) do { _Pragma("unroll") for (int _i = 0; _i < 2; ++_i) \
        __builtin_amdgcn_global_load_lds((const unsigned*)((const char*)(gbase) + (size_t)_i * r64##voff + voff_##voff), (LAS unsigned*)(lds + (bufoff) + ldsw + _i * 8192), 16, 0, 0); } while (0)
#define PG8_LDA(dst, b, h) do { _Pragma("unroll") for (int m = 0; m < 4; ++m) { if constexpr (F8) { const i32x4 _l = *(const LAS i32x4*)(lds + PG8_SA(b, h) + aoff + m * 2048), _h = *(const LAS i32x4*)(lds + PG8_SA(b, h) + aoff + m * 2048 + 1024); dst##8[m] = __builtin_shufflevector(_l, _h, 0, 1, 2, 3, 4, 5, 6, 7); } \
        else { _Pragma("unroll") for (int k = 0; k < 2; ++k) dst[m][k] = *(const LAS bf16x8*)(lds + PG8_SA(b, h) + aoff + m * 2048 + k * 1024); } } } while (0)
#define PG8_LDB(dst, b, h) do { _Pragma("unroll") for (int n = 0; n < 2; ++n) { if constexpr (F8) { const i32x4 _l = *(const LAS i32x4*)(lds + PG8_SB(b, h) + boff + n * 2048), _h = *(const LAS i32x4*)(lds + PG8_SB(b, h) + boff + n * 2048 + 1024); dst##8[n] = __builtin_shufflevector(_l, _h, 0, 1, 2, 3, 4, 5, 6, 7); } \
        else { _Pragma("unroll") for (int k = 0; k < 2; ++k) dst[n][k] = *(const LAS bf16x8*)(lds + PG8_SB(b, h) + boff + n * 2048 + k * 1024); } } } while (0)
#define PG8_MMA(ai, bj, At, Bt) do { __builtin_amdgcn_s_setprio(1); _Pragma("unroll") for (int m = 0; m < 4; ++m) _Pragma("unroll") for (int n = 0; n < 2; ++n) { \
        if constexpr (F8) acc[ai][bj][m][n] = __builtin_amdgcn_mfma_scale_f32_16x16x128_f8f6f4(Bt##8[n], At##8[m], acc[ai][bj][m][n], 0, 0, 0, 0, 0, 0);     \
        else { _Pragma("unroll") for (int k = 0; k < 2; ++k) acc[ai][bj][m][n] = __builtin_amdgcn_mfma_f32_16x16x32_bf16(Bt[n][k], At[m][k], acc[ai][bj][m][n], 0, 0, 0); } } \
        __builtin_amdgcn_s_setprio(0); } while (0)
#define PG8_WAIT_V(n) asm volatile("s_waitcnt vmcnt(" #n ")" ::: "memory")
#define PG8_WAIT_L(n) asm volatile("s_waitcnt lgkmcnt(" #n ")" ::: "memory")
#define PG8_BAR __builtin_amdgcn_s_barrier()
#define PG8_SCHED __builtin_amdgcn_sched_barrier(0)
    Unit cur, nxt; int ui = 0;
    if (!S.next(0, cur)) return;
    f32x4 acc[2][2][4][2];
#pragma unroll
    for (int a = 0; a < 2; ++a)
#pragma unroll
        for (int b = 0; b < 2; ++b)
#pragma unroll
            for (int m = 0; m < 4; ++m)
#pragma unroll
                for (int n = 0; n < 2; ++n) acc[a][b][m][n] = (f32x4){0.f, 0.f, 0.f, 0.f};
    bf16x8 At[4][2], B0[2][2], B1[2][2]; i32x8 At8[4], B08[2], B18[2];
    const char* cA = (const char*)(g.A + g.za.off(cur.z)) + (size_t)cur.pm * tstepA; const char* cB = (const char*)(g.Bt + g.zb.off(cur.z)) + (size_t)cur.pn * tstepB;
    if constexpr (SP2) {
        PG8_STAGE(PG8_SB(0, 0), cB, B); PG8_STAGE(PG8_SB(0, 1), cB + hstepB, B); PG8_STAGE(PG8_SA(0, 0), cA, A); PG8_STAGE(PG8_SA(0, 1), cA + hstepA, A);
        if (wr == 1) PG8_BAR;
        PG8_WAIT_V(2); PG8_BAR;
        PG8_STAGE(PG8_SB(1, 0), cB + kstep, B); PG8_STAGE(PG8_SA(1, 0), cA + kstep, A); PG8_STAGE(PG8_SB(1, 1), cB + hstepB + kstep, B);
        PG8_WAIT_V(6); PG8_BAR;
    } else {
        PG8_STAGE(PG8_SB(0, 0), cB, B); PG8_STAGE(PG8_SA(0, 0), cA, A); PG8_STAGE(PG8_SB(0, 1), cB + hstepB, B); PG8_STAGE(PG8_SA(0, 1), cA + hstepA, A);
        if (wr == 1) PG8_BAR;
        PG8_WAIT_V(4); PG8_BAR;
        PG8_STAGE(PG8_SB(1, 0), cB + kstep, B); PG8_STAGE(PG8_SA(1, 0), cA + kstep, A); PG8_STAGE(PG8_SB(1, 1), cB + hstepB + kstep, B);
        PG8_WAIT_V(6); PG8_BAR;
    }
    for (;;) {
        const bool has_next = S.next(ui + 1, nxt);
        const char* nA = has_next ? (const char*)(g.A + g.za.off(nxt.z)) + (size_t)nxt.pm * tstepA : cA; const char* nB = has_next ? (const char*)(g.Bt + g.zb.off(nxt.z)) + (size_t)nxt.pn * tstepB : cB;
        for (int t = 0; t < nt; t += 2) {
            const bool last = (t == nt - 2);
            const char* a1 = cA + (size_t)(t + 1) * kstep;
            const char* a2 = last ? nA : cA + (size_t)(t + 2) * kstep; const char* b2 = last ? nB : cB + (size_t)(t + 2) * kstep;
            const char* a3 = a2 + kstep; const char* b3 = b2 + kstep;
            if constexpr (SP2) {
            PG8_LDB(B0, 0, 0); PG8_LDB(B1, 0, 1); PG8_SCHED; PG8_LDA(At, 0, 0); PG8_STAGE(PG8_SA(1, 1), a1 + hstepA, A);
            PG8_WAIT_V(8); PG8_WAIT_L(0); PG8_BAR; PG8_MMA(0, 0, At, B0); PG8_MMA(0, 1, At, B1); PG8_BAR; PG8_SCHED;
            PG8_LDA(At, 0, 1); PG8_STAGE(PG8_SB(0, 0), b2, B); PG8_STAGE(PG8_SB(0, 1), b2 + hstepB, B); PG8_STAGE(PG8_SA(0, 0), a2, A);
            PG8_WAIT_V(8); PG8_WAIT_L(0); PG8_BAR; PG8_MMA(1, 0, At, B0); PG8_MMA(1, 1, At, B1); PG8_BAR; PG8_SCHED;
            PG8_LDB(B0, 1, 0); PG8_LDB(B1, 1, 1); PG8_SCHED; PG8_LDA(At, 1, 0); PG8_STAGE(PG8_SA(0, 1), a2 + hstepA, A);
            PG8_WAIT_V(8); PG8_WAIT_L(0); PG8_BAR; PG8_MMA(0, 0, At, B0); PG8_MMA(0, 1, At, B1); PG8_BAR; PG8_SCHED;
            PG8_LDA(At, 1, 1); PG8_STAGE(PG8_SB(1, 0), b3, B); PG8_STAGE(PG8_SB(1, 1), b3 + hstepB, B); PG8_STAGE(PG8_SA(1, 0), a3, A);
            PG8_WAIT_V(8); PG8_WAIT_L(0); PG8_BAR; PG8_MMA(1, 0, At, B0); PG8_MMA(1, 1, At, B1); PG8_BAR; PG8_SCHED;
            } else {
            PG8_LDB(B0, 0, 0); PG8_SCHED; PG8_LDA(At, 0, 0); PG8_STAGE(PG8_SA(1, 1), a1 + hstepA, A);
            PG8_WAIT_L(8); PG8_BAR; PG8_WAIT_L(0); PG8_MMA(0, 0, At, B0); PG8_BAR; PG8_SCHED;
            PG8_LDB(B1, 0, 1); PG8_STAGE(PG8_SB(0, 0), b2, B);
            PG8_BAR; PG8_WAIT_L(0); PG8_MMA(0, 1, At, B1); PG8_BAR;
            PG8_LDA(At, 0, 1); PG8_STAGE(PG8_SA(0, 0), a2, A);
            PG8_BAR; PG8_WAIT_L(0); PG8_MMA(1, 0, At, B0); PG8_BAR; PG8_SCHED;
            PG8_STAGE(PG8_SB(0, 1), b2 + hstepB, B);
            PG8_WAIT_V(6); PG8_BAR; PG8_MMA(1, 1, At, B1); PG8_BAR;
            PG8_LDB(B0, 1, 0); PG8_SCHED; PG8_LDA(At, 1, 0); PG8_STAGE(PG8_SA(0, 1), a2 + hstepA, A);
            PG8_WAIT_L(8); PG8_BAR; PG8_WAIT_L(0); PG8_MMA(0, 0, At, B0); PG8_BAR; PG8_SCHED;
            PG8_LDB(B1, 1, 1); PG8_STAGE(PG8_SB(1, 0), b3, B);
            PG8_BAR; PG8_WAIT_L(0); PG8_MMA(0, 1, At, B1); PG8_BAR;
            PG8_LDA(At, 1, 1); PG8_STAGE(PG8_SA(1, 0), a3, A);
            PG8_BAR; PG8_WAIT_L(0); PG8_MMA(1, 0, At, B0); PG8_BAR; PG8_SCHED;
            PG8_STAGE(PG8_SB(1, 1), b3 + hstepB, B);
            PG8_WAIT_V(6); PG8_BAR; PG8_MMA(1, 1, At, B1); PG8_BAR;
            }
        }
        if constexpr (ALIGN_EPI) { if (wr == 0) PG8_BAR; }
        if constexpr (!Epi::AFTER_DRAIN) {
            const int lz = lane_id(); E(acc, cur, wr, wc, lz & 15, lz >> 4); }
        if (!has_next) break;
#pragma unroll
        for (int a = 0; a < 2; ++a)
#pragma unroll
            for (int b = 0; b < 2; ++b)
#pragma unroll
                for (int m = 0; m < 4; ++m)
#pragma unroll
                    for (int n = 0; n < 2; ++n) acc[a][b][m][n] = (f32x4){0.f, 0.f, 0.f, 0.f};
        cur = nxt; cA = nA; cB = nB; ++ui;
        if constexpr (ALIGN_EPI) { if (wr == 1) PG8_BAR; }
    }
    PG8_WAIT_V(0);
    if constexpr (!ALIGN_EPI) { if (wr == 0) PG8_BAR; }
    PG8_BAR;
    if constexpr (Epi::AFTER_DRAIN) { const int lz = lane_id(); E.fused(acc, cur, wr, wc, lz & 15, lz >> 4, lds, wid, lz); }
#undef PG8_SA
#undef PG8_SB
#undef PG8_STAGE
#undef PG8_LDA
#undef PG8_LDB
#undef PG8_MMA
#undef PG8_WAIT_V
#undef PG8_WAIT_L
#undef PG8_BAR
#undef PG8_SCHED
}

struct EpiF32 {
    static constexpr bool PERM = false, AFTER_DRAIN = false;
    float* C; int ldc;
    DI void operator()(const f32x4 (&acc)[2][2][4][2], const Unit& u, int wr, int wc, int fr, int fq) const {
        const int row0 = u.pm * BM + wr * 64 + fr, col0 = u.pn * BM + wc * 32 + 4 * fq;
#pragma unroll
        for (int ai = 0; ai < 2; ++ai)
#pragma unroll
            for (int m = 0; m < 4; ++m) { float* rowp = C + (size_t)(row0 + ai * HALF + m * 16) * ldc + col0;
#pragma unroll
                for (int bj = 0; bj < 2; ++bj)
#pragma unroll
                    for (int n = 0; n < 2; ++n) *(f32x4*)(rowp + bj * HALF + n * 16) = acc[ai][bj][m][n]; }
    }
};
struct EpiBf16 {
    static constexpr bool PERM = true, AFTER_DRAIN = false;
    bf16_t* O; int ldc; BatchOff zo; int fl_tile; float* FL;
    DI void operator()(const f32x4 (&acc)[2][2][4][2], const Unit& u, int wr, int wc, int fr, int fq) const {
        const int row0 = u.pm * BM + wr * 64 + fr, col0 = u.pn * BM + wc * 32 + 8 * fq;
        bf16_t* base = O + zo.off(u.z);
#pragma unroll
        for (int ai = 0; ai < 2; ++ai)
#pragma unroll
            for (int m = 0; m < 4; ++m) { bf16_t* rowp = base + (size_t)(row0 + ai * HALF + m * 16) * ldc + col0;
#pragma unroll
                for (int bj = 0; bj < 2; ++bj) { const f32x4 v0 = acc[ai][bj][m][0], v1 = acc[ai][bj][m][1];
                    u32x4 w; w.x = pk2(v0[0], v0[1]); w.y = pk2(v0[2], v0[3]); w.z = pk2(v1[0], v1[1]); w.w = pk2(v1[2], v1[3]);
                    *(u32x4*)(rowp + bj * HALF) = w; } }
        if (u.pn == fl_tile && wc == 2 && fq < 2) {
#pragma unroll
            for (int ai = 0; ai < 2; ++ai)
#pragma unroll
                for (int m = 0; m < 4; ++m) { float* p = FL + (size_t)(row0 + ai * HALF + m * 16) * 16 + 8 * fq;
                    *(f32x4*)p = acc[ai][1][m][0]; *(f32x4*)(p + 4) = acc[ai][1][m][1]; }
        }
    }
};
struct EpiBf16R {
    static constexpr bool PERM = true, AFTER_DRAIN = false;
    bf16_t* O; int ldc; int fl_tile; float* FL; const float* rs;
    DI void operator()(const f32x4 (&acc)[2][2][4][2], const Unit& u, int wr, int wc, int fr, int fq) const {
        const int row0 = u.pm * BM + wr * 64 + fr, col0 = u.pn * BM + wc * 32 + 8 * fq;
#pragma unroll
        for (int ai = 0; ai < 2; ++ai)
#pragma unroll
            for (int m = 0; m < 4; ++m) { const int row = row0 + ai * HALF + m * 16; const float r = rs[row]; bf16_t* rowp = O + (size_t)row * ldc + col0;
#pragma unroll
                for (int bj = 0; bj < 2; ++bj) { const f32x4 v0 = acc[ai][bj][m][0] * r, v1 = acc[ai][bj][m][1] * r;
                    u32x4 w; w.x = pk2(v0[0], v0[1]); w.y = pk2(v0[2], v0[3]); w.z = pk2(v1[0], v1[1]); w.w = pk2(v1[2], v1[3]);
                    *(u32x4*)(rowp + bj * HALF) = w; }
                if (u.pn == fl_tile && wc == 2 && fq < 2) { float* p = FL + (size_t)row * 16 + 8 * fq; *(f32x4*)p = acc[ai][1][m][0] * r; *(f32x4*)(p + 4) = acc[ai][1][m][1] * r; } }
    }
};
struct EpiSwiGLU {
    static constexpr bool PERM = true, AFTER_DRAIN = false;
    bf16_t* O; int ldc; float sc;
    DI void operator()(const f32x4 (&acc)[2][2][4][2], const Unit& u, int wr, int wc, int fr, int fq) const {
        const int row0 = u.pm * BM + wr * 64 + fr, col0 = u.pn * HALF + wc * 32 + 8 * fq;
#pragma unroll
        for (int ai = 0; ai < 2; ++ai)
#pragma unroll
            for (int m = 0; m < 4; ++m) { float h[8];
#pragma unroll
                for (int n = 0; n < 2; ++n)
#pragma unroll
                    for (int j = 0; j < 4; ++j) { const float gt = acc[ai][0][m][n][j] * sc, up = acc[ai][1][m][n][j] * sc;
                        h[4 * n + j] = gt * __builtin_amdgcn_rcpf(1.0f + __builtin_amdgcn_exp2f(-gt * LOG2E)) * up; }
                u32x4 w; w.x = pk2(h[0], h[1]); w.y = pk2(h[2], h[3]); w.z = pk2(h[4], h[5]); w.w = pk2(h[6], h[7]);
                *(u32x4*)(O + (size_t)(row0 + ai * HALF + m * 16) * ldc + col0) = w; }
    }
};
struct EpiSwiGLU8 {
    static constexpr bool PERM = false, AFTER_DRAIN = false;
    unsigned char* O; int ldc; float sc;
    DI void operator()(const f32x4 (&acc)[2][2][4][2], const Unit& u, int wr, int wc, int fr, int fq) const {
        const int row0 = u.pm * BM + wr * 64 + fr, col0 = u.pn * HALF + wc * 32 + 4 * fq;
#pragma unroll
        for (int ai = 0; ai < 2; ++ai)
#pragma unroll
            for (int m = 0; m < 4; ++m)
#pragma unroll
                for (int n = 0; n < 2; ++n) { float h[4];
#pragma unroll
                    for (int j = 0; j < 4; ++j) { const float gt = acc[ai][0][m][n][j] * sc, up = acc[ai][1][m][n][j] * sc;
                        h[j] = __builtin_amdgcn_fmed3f(gt * __builtin_amdgcn_rcpf(1.0f + __builtin_amdgcn_exp2f(-gt * LOG2E)) * up * 16.0f, -448.0f, 448.0f); }
                    int w = __builtin_amdgcn_cvt_pk_fp8_f32(h[0], h[1], 0, false); w = __builtin_amdgcn_cvt_pk_fp8_f32(h[2], h[3], w, true);
                    *(unsigned*)(O + (size_t)(row0 + ai * HALF + m * 16) * ldc + col0 + 16 * n) = (unsigned)w; }
    }
};
struct EpiBf16S {
    static constexpr bool PERM = false, AFTER_DRAIN = false;
    bf16_t* O; int ldc; float sc;
    DI void operator()(const f32x4 (&acc)[2][2][4][2], const Unit& u, int wr, int wc, int fr, int fq) const {
        const int row0 = u.pm * BM + wr * 64 + fr, col0 = u.pn * BM + wc * 32 + 4 * fq;
#pragma unroll
        for (int ai = 0; ai < 2; ++ai)
#pragma unroll
            for (int m = 0; m < 4; ++m) { bf16_t* rowp = O + (size_t)(row0 + ai * HALF + m * 16) * ldc + col0;
#pragma unroll
                for (int bj = 0; bj < 2; ++bj)
#pragma unroll
                    for (int n = 0; n < 2; ++n) { const f32x4 v = acc[ai][bj][m][n] * sc; u32x2 w; w.x = pk2(v[0], v[1]); w.y = pk2(v[2], v[3]); *(u32x2*)(rowp + bj * HALF + n * 16) = w; } }
    }
};
template <int MODE> struct EpiLora {
    static constexpr bool PERM = true, AFTER_DRAIN = false;
    const float* vec; float* Of; bf16_t* Ob;
    DI void operator()(const f32x4 (&acc)[2][2][4][2], const Unit& u, int wr, int wc, int fr, int fq) const {
        const int row0 = u.pm * BM + wr * 64 + fr, col0 = u.pn * BM + wc * 32 + 8 * fq;
#pragma unroll
        for (int bj = 0; bj < 2; ++bj) {
            f32x4 b0 = (f32x4){0.f, 0.f, 0.f, 0.f}, b1 = b0;
            if (MODE < 2) { b0 = *(const f32x4*)(vec + col0 + bj * HALF); b1 = *(const f32x4*)(vec + col0 + bj * HALF + 4); }
#pragma unroll
            for (int ai = 0; ai < 2; ++ai)
#pragma unroll
                for (int m = 0; m < 4; ++m) { const size_t o = (size_t)(row0 + ai * HALF + m * 16) * RW + col0 + bj * HALF;
                    f32x4 v0 = acc[ai][bj][m][0] + b0, v1 = acc[ai][bj][m][1] + b1;
                    if (MODE == 2) { u32x4 w; w.x = pk2(v0[0], v0[1]); w.y = pk2(v0[2], v0[3]); w.z = pk2(v1[0], v1[1]); w.w = pk2(v1[2], v1[3]); *(u32x4*)(Ob + o) = w; }
                    else {
#pragma unroll
                        for (int j = 0; j < 4; ++j) {
                            if (MODE == 0) { v0[j] = __expf(-__expf(-(fmaxf(-v0[j], 0.f) + __logf(1.0f + __expf(-fabsf(v0[j])))) - 0.5f)); v1[j] = __expf(-__expf(-(fmaxf(-v1[j], 0.f) + __logf(1.0f + __expf(-fabsf(v1[j])))) - 0.5f)); }
                            else { v0[j] = 1.0f / (1.0f + __expf(-v0[j])); v1[j] = 1.0f / (1.0f + __expf(-v1[j])); } }
                        *(f32x4*)(Of + o) = v0; *(f32x4*)(Of + o + 4) = v1; } }
        }
    }
};
struct EpiSoftmax {
    static constexpr bool PERM = true, AFTER_DRAIN = true;
    bf16_t* P; float scale2;
    DI void fused(f32x4 (&acc)[2][2][4][2], const Unit& u, int wr, int wc, int fr, int fq, LAS unsigned char* lds, int wid, int lane) const {
        LAS float* PM = (LAS float*)lds;
        LAS float* PS = (LAS float*)(lds + 4096);
        float mx[2][4];
#pragma unroll
        for (int ai = 0; ai < 2; ++ai)
#pragma unroll
            for (int m = 0; m < 4; ++m) { float v = -3.0e38f;
#pragma unroll
                for (int bj = 0; bj < 2; ++bj)
#pragma unroll
                    for (int n = 0; n < 2; ++n)
#pragma unroll
                        for (int j = 0; j < 4; ++j) v = fmaxf(v, acc[ai][bj][m][n][j]);
                v = fmaxf(v, __shfl_xor(v, 16)); v = fmaxf(v, __shfl_xor(v, 32));
                if (fq == 0) PM[(ai * HALF + wr * 64 + m * 16 + fr) * 4 + wc] = v; }
        asm volatile("s_waitcnt lgkmcnt(0)" ::: "memory"); __builtin_amdgcn_s_barrier(); asm volatile("" ::: "memory");
#pragma unroll
        for (int ai = 0; ai < 2; ++ai)
#pragma unroll
            for (int m = 0; m < 4; ++m) { const int r = ai * HALF + wr * 64 + m * 16 + fr; const f32x4 pm = *(const LAS f32x4*)(PM + r * 4);
                const float mxv = fmaxf(fmaxf(pm[0], pm[1]), fmaxf(pm[2], pm[3])) * scale2; mx[ai][m] = mxv; float s = 0.f;
#pragma unroll
                for (int bj = 0; bj < 2; ++bj)
#pragma unroll
                    for (int n = 0; n < 2; ++n)
#pragma unroll
                        for (int j = 0; j < 4; ++j) { const float e = __builtin_amdgcn_exp2f(acc[ai][bj][m][n][j] * scale2 - mxv); acc[ai][bj][m][n][j] = e; s += e; }
                s += __shfl_xor(s, 16); s += __shfl_xor(s, 32);
                if (fq == 0) PS[r * 4 + wc] = s; }
        asm volatile("s_waitcnt lgkmcnt(0)" ::: "memory"); __builtin_amdgcn_s_barrier(); asm volatile("" ::: "memory");
        bf16_t* base = P + (size_t)u.z * SEQ * NMEM;
        const int col0 = wc * 32 + 8 * fq;
#pragma unroll
        for (int ai = 0; ai < 2; ++ai)
#pragma unroll
            for (int m = 0; m < 4; ++m) { const int r = ai * HALF + wr * 64 + m * 16 + fr; const f32x4 ps = *(const LAS f32x4*)(PS + r * 4);
                const float inv = 1.0f / ((ps[0] + ps[1]) + (ps[2] + ps[3]));
                bf16_t* rowp = base + (size_t)(u.pm * BM + r) * NMEM + col0;
#pragma unroll
                for (int bj = 0; bj < 2; ++bj) { const f32x4 v0 = acc[ai][bj][m][0] * inv, v1 = acc[ai][bj][m][1] * inv;
                    u32x4 w; w.x = pk2(v0[0], v0[1]); w.y = pk2(v0[2], v0[3]); w.z = pk2(v1[0], v1[1]); w.w = pk2(v1[2], v1[3]);
                    *(u32x4*)(rowp + bj * HALF) = w; } }
        (void)mx; (void)wid; (void)lane;
    }
};
}

#define XB_TMO      128
#define XB_XCNT(j)  (256  + 64 * (j))
#define XB_XSUB(j)  (1280 + 64 * (j))
#define XB_XGEN(j)  (2304 + 64 * (j))
#define XB_TOP      3328
#define XB_TOPGEN   3392
#define XCD_BAR_WORDS 3456
#define XB_SPIN_CAP (1u << 22)
DI unsigned xb_ld(unsigned* p)              { return __hip_atomic_load(p, __ATOMIC_RELAXED, __HIP_MEMORY_SCOPE_AGENT); }
DI unsigned xb_add(unsigned* p, unsigned v) { return __hip_atomic_fetch_add(p, v, __ATOMIC_RELAXED, __HIP_MEMORY_SCOPE_AGENT); }
DI unsigned xb_xcc_id() { return (unsigned)__builtin_amdgcn_s_getreg((3 << 11) | 20) & 0xFu; }
#define XB_SPIN(cond, bar) do { unsigned _sp = 0; while (cond) { __builtin_amdgcn_s_sleep(1); \
    if ((++_sp & 255u) == 0u) { if (xb_ld(&(bar)[XB_TMO])) break; if (_sp > XB_SPIN_CAP) { atomicAdd(&(bar)[XB_TMO], 1u); break; } } } } while (0)
struct XcdBarrier { unsigned* bar; unsigned x; volatile LAS unsigned* st; int wave; };
DI XcdBarrier xcd_barrier_post(unsigned* bar, volatile LAS unsigned* st, int wave) {
    XcdBarrier b; b.bar = bar; b.x = xb_xcc_id(); b.st = st; b.wave = wave;
    if (wave == 0 && lane_id() == 0) (void)xb_add(&bar[XB_XCNT(b.x)], 1u);
    return b;
}
DI void xcd_barrier_complete(unsigned* bar, unsigned x, unsigned& nloc, unsigned& nx) {
    const unsigned G = gridDim.x * gridDim.y * gridDim.z;
    unsigned sum, cnt, mine, sp = 0u;
    for (;;) {
        sum = 0u; cnt = 0u; mine = 0u;
#pragma unroll
        for (unsigned j = 0; j < 16; ++j) { const unsigned c = xb_ld(&bar[XB_XCNT(j)]); sum += c; cnt += (c > 0u) ? 1u : 0u; mine = (j == x) ? c : mine; }
        if (sum == G) break;
        __builtin_amdgcn_s_sleep(1);
        if ((++sp & 255u) == 0u) { if (xb_ld(&bar[XB_TMO])) break; if (sp > XB_SPIN_CAP) { atomicAdd(&bar[XB_TMO], 1u); break; } }
    }
    nloc = mine > 0u ? mine : 1u; nx = cnt > 0u ? cnt : 1u;
}
DI void xcd_barrier(const XcdBarrier& b) {
    asm volatile("s_waitcnt vmcnt(0)" ::: "memory");
    __syncthreads();
    if (b.wave == 0 && lane_id() == 0) {
        unsigned* bar = b.bar;
        __builtin_amdgcn_s_waitcnt(0);
        unsigned nloc = b.st[0], nx = b.st[1];
        if (nloc == 0u) { xcd_barrier_complete(bar, b.x, nloc, nx); b.st[0] = nloc; b.st[1] = nx; }
        const unsigned old = xb_add(&bar[XB_XSUB(b.x)], 1u);
        const unsigned gen = old / nloc;
        if (old + 1u == (gen + 1u) * nloc) {
            __builtin_amdgcn_fence(__ATOMIC_RELEASE, "agent");
            asm volatile("s_waitcnt vmcnt(0)" ::: "memory");
            const unsigned og = xb_add(&bar[XB_TOP], 1u);
            const unsigned tg = og / nx;
            if (og + 1u == (tg + 1u) * nx) xb_add(&bar[XB_TOPGEN], 1u);
            else XB_SPIN(xb_ld(&bar[XB_TOPGEN]) == tg, bar);
            __builtin_amdgcn_fence(__ATOMIC_ACQUIRE, "agent");
            xb_add(&bar[XB_XGEN(b.x)], 1u);
            asm volatile("s_waitcnt vmcnt(0)" ::: "memory");
        } else {
            XB_SPIN(xb_ld(&bar[XB_XGEN(b.x)]) == gen, bar);
            __builtin_amdgcn_fence(__ATOMIC_ACQUIRE, "agent");
            asm volatile("s_waitcnt vmcnt(0)" ::: "memory");
        }
    }
    __syncthreads();
}

constexpr int NWAVES = 8, NTHR = 512;
constexpr int RING_BYTES = 131072;
constexpr int LDS_BYTES = 147456;
constexpr int MISC_OFF = LDS_BYTES - 1024;
constexpr int CW_BAR = 4096;

struct Args { const float* in[35]; float* out; unsigned char* ws; int ph_lo, ph_hi; };
typedef const __attribute__((address_space(4))) Args CArgs;
enum { I_X = 0, I_MEM, I_F1PRE, I_F1G, I_F1U, I_F1D, I_F1POST, I_MIXPRE, I_WIN, I_FBIAS, I_MU, I_W0, I_WUP, I_A0, I_AUP, I_GUP, I_KK, I_KA, I_RK, I_LNW, I_LNB,
       I_WOUT, I_MIXPOST, I_XPRE, I_MEMG, I_WQ, I_WK, I_WV, I_WO, I_XPOST, I_F2PRE, I_F2G, I_F2U, I_F2D, I_F2POST };

DI float wave_sum(float v) {
#pragma unroll
    for (int o = 1; o < 64; o <<= 1) v += __shfl_xor(v, o);
    return v;
}

struct CvtJob { const float* W; const float* gk; int ldw, K, Kpad, col0, ncols; bf16* dst; int ldk, row0, mode, f8; };
DI void cvt_item(const CvtJob& J, int item, LAS float* scr, int lane) {
    const int nblk = (J.ncols + 63) >> 6, kb = item / nblk, nb = item - kb * nblk, k0 = kb * 64, n0 = nb * 64;
    const int nvalid = J.ncols - n0;
    const int c4 = lane & 15, kr = lane >> 4;
    f32x4 v[16];
    if (nvalid >= 64 && k0 + 64 <= J.K) {
        const GAS f32x4* src = (const GAS f32x4*)(J.W + (size_t)(k0 + kr) * J.ldw + J.col0 + n0 + 4 * c4); const size_t rs = (size_t)J.ldw;
#pragma unroll
        for (int i = 0; i < 16; ++i) v[i] = src[(size_t)i * rs];
    } else {
#pragma unroll
        for (int i = 0; i < 16; ++i) { const int k = k0 + 4 * i + kr;
            v[i] = (4 * c4 < nvalid && k < J.K) ? *(const GAS f32x4*)(J.W + (size_t)k * J.ldw + J.col0 + n0 + 4 * c4) : (f32x4){0.f, 0.f, 0.f, 0.f}; }
    }
    if (J.gk) {
#pragma unroll
        for (int i = 0; i < 16; ++i) { const int k = k0 + 4 * i + kr; const float gg = k < J.K ? J.gk[k] : 0.f; v[i] = v[i] * gg; } }
#pragma unroll
    for (int i = 0; i < 16; ++i) { const int k = 4 * i + kr; *(LAS f32x4*)(scr + k * 64 + ((4 * c4) ^ (((k >> 3) & 7) << 2))) = v[i]; }
    asm volatile("s_waitcnt lgkmcnt(0)" ::: "memory");
    if (J.f8) {
#pragma unroll
        for (int j = 0; j < 4; ++j) { const int p = j * 64 + lane, n = p >> 2, c = p & 3;
            unsigned o[4];
#pragma unroll
            for (int q = 0; q < 4; ++q) { const int e = 4 * q; const LAS float* sp = scr + (16 * c + e) * 64 + (n ^ ((2 * c + (e >> 3)) << 2));
                int w = __builtin_amdgcn_cvt_pk_fp8_f32(__builtin_amdgcn_fmed3f(sp[0] * 64.0f, -448.0f, 448.0f), __builtin_amdgcn_fmed3f(sp[64] * 64.0f, -448.0f, 448.0f), 0, false);
                w = __builtin_amdgcn_cvt_pk_fp8_f32(__builtin_amdgcn_fmed3f(sp[128] * 64.0f, -448.0f, 448.0f), __builtin_amdgcn_fmed3f(sp[192] * 64.0f, -448.0f, 448.0f), w, true); o[q] = (unsigned)w; }
            if (n < nvalid) { const int ng = n0 + n; const int drow = (J.mode == 0) ? (J.row0 + ng) : ((ng >> 7) * 256 + (ng & 127) + (J.mode == 2 ? 128 : 0));
                *(GAS u32x4*)((unsigned char*)J.dst + (size_t)drow * J.ldk + k0 + 16 * c) = (u32x4){o[0], o[1], o[2], o[3]}; } }
    } else {
#pragma unroll
    for (int j = 0; j < 8; ++j) { const int p = j * 64 + lane, n = p >> 3, c = p & 7;
        const LAS float* s = scr + (8 * c) * 64 + (n ^ (c << 2));
        u32x4 o; o.x = pk2(s[0], s[64]); o.y = pk2(s[128], s[192]); o.z = pk2(s[256], s[320]); o.w = pk2(s[384], s[448]);
        if (n < nvalid) { const int ng = n0 + n; const int drow = (J.mode == 0) ? (J.row0 + ng) : ((ng >> 7) * 256 + (ng & 127) + (J.mode == 2 ? 128 : 0));
            *(GAS u32x4*)(J.dst + (size_t)drow * J.ldk + k0 + 8 * c) = o; } }
    }
    asm volatile("s_waitcnt lgkmcnt(0)" ::: "memory");
}
constexpr int CI_FF = 64 * 172, CI_INA = 64 * 96, CI_INC = 64 * 7, CI_IND = 64, CI_SQ = 64 * 64, CI_LORA = 4 * 32;
constexpr int CVT_NITEMS = 6 * CI_FF + 2 * CI_INA + CI_INC + CI_IND + 5 * CI_SQ + 3 * CI_LORA;
constexpr int CVT_EARLY = 3 * CI_FF + 2 * CI_INA + CI_INC + CI_IND + 2 * CI_SQ + 3 * CI_LORA;
DI bool cvt_pick(CArgs& a, int it, CvtJob& J, int& local) {
    unsigned char* ws = a.ws;
#define CJ(cnt, Wp, ldw_, K_, Kpad_, col0_, ncols_, dst_, ldk_, row0_, mode_) \
    if (it < (cnt)) { J.W = (Wp); J.ldw = (ldw_); J.K = (K_); J.Kpad = (Kpad_); J.col0 = (col0_); J.ncols = (ncols_); J.dst = (bf16*)(ws + (dst_)); J.ldk = (ldk_); J.row0 = (row0_); J.mode = (mode_) & 3; J.f8 = ((mode_) >> 2) & 3; J.gk = ((mode_) >> 4) == 1 ? a.in[I_MIXPRE] : ((mode_) >> 4) == 2 ? a.in[I_XPRE] : nullptr; local = it; return true; } it -= (cnt);
    CJ(CI_FF, a.in[I_F1G], FF, D, D, 0, FF, WS_F1GU, D, 0, 1)
    CJ(CI_FF, a.in[I_F1U], FF, D, D, 0, FF, WS_F1GU, D, 0, 2)
    CJ(CI_FF, a.in[I_F1D], D, FF, FF, 0, D, WS_F1D, FF, 0, 0)
    CJ(CI_INA, a.in[I_WIN], IN_COLS, D, D, 0, 6144, WS_W_IN, D, 0, 0 + 16)
    CJ(CI_INA, a.in[I_WIN], IN_COLS, D, D, 6160, 6144, WS_W_IN, D, PC_RKV, 0 + 16)
    CJ(CI_INC, a.in[I_WIN], IN_COLS, D, D, 12304, 448, WS_W_IN, D, PC_LORA, 0 + 16)
    CJ(CI_IND, a.in[I_WIN], IN_COLS, D, D, 6144, 16, WS_W_IN, D, PC_FL, 0 + 16)
    CJ(CI_SQ, a.in[I_WK], D, D, D, 0, D, WS_WK, D, 0, 0)
    CJ(CI_SQ, a.in[I_WV], D, D, D, 0, D, WS_WV, D, 0, 0)
    CJ(CI_LORA, a.in[I_WUP], RW, 96, LORA_K, 0, RW, WS_LORAW, LORA_K, 0, 0)
    CJ(CI_LORA, a.in[I_AUP], RW, 96, LORA_K, 0, RW, WS_LORAW, LORA_K, RW, 0)
    CJ(CI_LORA, a.in[I_GUP], RW, 256, LORA_K, 0, RW, WS_LORAW, LORA_K, 2 * RW, 0)
    CJ(CI_SQ, a.in[I_WOUT], D, D, D, 0, D, WS_W_OUT, D, 0, 0)
    CJ(CI_SQ, a.in[I_WQ], D, D, D, 0, D, WS_WQ, D, 0, 0 + 32)
    CJ(CI_SQ, a.in[I_WO], D, D, D, 0, D, WS_WO, D, 0, 0)
    CJ(CI_FF, a.in[I_F2G], FF, D, D, 0, FF, WS_F2GU, D, 0, 1 + 4)
    CJ(CI_FF, a.in[I_F2U], FF, D, D, 0, FF, WS_F2GU, D, 0, 2 + 4)
    CJ(CI_FF, a.in[I_F2D], D, FF, FF, 0, D, WS_F2D, FF, 0, 0 + 4)
#undef CJ
    return false;
}
DI void rms_row_to_bf16(const float* xrow, const float* g, bf16* orow, int lane) {
    const GAS f32x4* xr = (const GAS f32x4*)xrow + lane; const GAS f32x4* gr = (const GAS f32x4*)g + lane;
    f32x4 v[16]; float s = 0.f;
#pragma unroll
    for (int j = 0; j < 16; ++j) { v[j] = xr[64 * j]; s += (v[j].x * v[j].x + v[j].y * v[j].y) + (v[j].z * v[j].z + v[j].w * v[j].w); }
    const float rstd = 1.0f / sqrtf(wave_sum(s) * (1.0f / D) + RMS_EPS);
    GAS u32x2* o8 = (GAS u32x2*)orow + lane;
#pragma unroll
    for (int j = 0; j < 16; ++j) { const f32x4 gg = gr[64 * j]; u32x2 w; w.x = pk2(v[j].x * rstd * gg.x, v[j].y * rstd * gg.y); w.y = pk2(v[j].z * rstd * gg.z, v[j].w * rstd * gg.w); o8[64 * j] = w; }
}
DI void p0_prologue(CArgs& a, LAS unsigned char* lds, int wave, int lane) {
    LAS float* scr = (LAS float*)(lds + wave * 16384);
    const int gw = blockIdx.x * NWAVES + wave, NGW = gridDim.x * NWAVES;
    if (P0_PARTS & 1) for (int it = CVT_LO + gw; it < CVT_HI; it += NGW) { CvtJob J; int local; if (cvt_pick(a, it, J, local)) cvt_item(J, local, scr, lane); }
    if (P0_PARTS & 2) { bf16* wi = (bf16*)(a.ws + WS_W_IN) + (size_t)12752 * D; const int nchunk = 48 * D / 8;
      for (int i = gw * 64 + lane; i < nchunk; i += NGW * 64) *(GAS u32x4*)(wi + (size_t)i * 8) = (u32x4){0u, 0u, 0u, 0u}; }
    bf16* H = (bf16*)(a.ws + WS_H); bf16* MEMN = (bf16*)(a.ws + WS_MEMN);
    if (P0_PARTS & 4) for (int m = gw; m < M; m += NGW) rms_row_to_bf16(a.in[I_X] + (size_t)m * D, a.in[I_F1PRE], H + (size_t)m * D, lane);
    if (P0_PARTS & 4) for (int m = gw; m < MM; m += NGW) rms_row_to_bf16(a.in[I_MEM] + (size_t)m * D, a.in[I_MEMG], MEMN + (size_t)m * D, lane);
}

DI void tail_cvt(CArgs& a, LAS unsigned char* lds, int wave, int lane, int first, int count, int r, int nidle) {
    LAS float* scr = (LAS float*)(lds + wave * 16384);
    for (int it = r * NWAVES + wave; it < count; it += nidle * NWAVES) { CvtJob J; int local; if (cvt_pick(a, first + it, J, local)) cvt_item(J, local, scr, lane); }
}
constexpr int CVT_TAIL = 6144;
template <bool H8, bool XIN32, bool XOUT32> DI void seam_phase(const void* xin_, const bf16* Y, void* xout_, bf16* H, const float* g_post, const float* g_pre, float alpha, int wave, int lane, float* rstd_out = nullptr) {
    const int gw = blockIdx.x * NWAVES + wave, NGW = gridDim.x * NWAVES;
    for (int m = gw; m < M; m += NGW) {
        const GAS u32x4* yr = (const GAS u32x4*)(Y + (size_t)m * D) + lane;
        float y[8][8], x[8][8]; float s = 0.f;
#pragma unroll
        for (int j = 0; j < 8; ++j) { const u32x4 yy = yr[64 * j];
#pragma unroll
            for (int e = 0; e < 4; ++e) { y[j][2 * e] = bflo(yy[e]); y[j][2 * e + 1] = bfhi(yy[e]); } }
        if constexpr (XIN32) { const GAS f32x4* xr = (const GAS f32x4*)((const float*)xin_ + (size_t)m * D) + 2 * lane;
#pragma unroll
            for (int j = 0; j < 8; ++j) { const f32x4 a0 = xr[128 * j], a1 = xr[128 * j + 1]; x[j][0] = a0[0]; x[j][1] = a0[1]; x[j][2] = a0[2]; x[j][3] = a0[3]; x[j][4] = a1[0]; x[j][5] = a1[1]; x[j][6] = a1[2]; x[j][7] = a1[3]; } }
        else { const GAS u32x4* xr = (const GAS u32x4*)((const bf16*)xin_ + (size_t)m * D) + lane;
#pragma unroll
            for (int j = 0; j < 8; ++j) { const u32x4 xx = xr[64 * j];
#pragma unroll
                for (int e = 0; e < 4; ++e) { x[j][2 * e] = bflo(xx[e]); x[j][2 * e + 1] = bfhi(xx[e]); } } }
#pragma unroll
        for (int j = 0; j < 8; ++j)
#pragma unroll
            for (int e = 0; e < 8; ++e) s += y[j][e] * y[j][e];
        const float ry = alpha / sqrtf(wave_sum(s) * (1.0f / D) + RMS_EPS);
        float s2 = 0.f; const GAS f32x4* gp = (const GAS f32x4*)g_post + 2 * lane;
#pragma unroll
        for (int j = 0; j < 8; ++j) { const f32x4 g0 = gp[128 * j], g1 = gp[128 * j + 1];
#pragma unroll
            for (int e = 0; e < 8; ++e) { const float gg = (e < 4) ? g0[e] : g1[e - 4]; x[j][e] = x[j][e] + y[j][e] * ry * gg; s2 += x[j][e] * x[j][e]; }
            if constexpr (XOUT32) { GAS f32x4* xo = (GAS f32x4*)((float*)xout_ + (size_t)m * D) + 2 * lane; xo[128 * j] = (f32x4){x[j][0], x[j][1], x[j][2], x[j][3]}; xo[128 * j + 1] = (f32x4){x[j][4], x[j][5], x[j][6], x[j][7]}; }
            else { u32x4 w; w.x = pk2(x[j][0], x[j][1]); w.y = pk2(x[j][2], x[j][3]); w.z = pk2(x[j][4], x[j][5]); w.w = pk2(x[j][6], x[j][7]); ((GAS u32x4*)((bf16*)xout_ + (size_t)m * D) + lane)[64 * j] = w; } }
        if (g_pre) {
            const float rx = 1.0f / sqrtf(wave_sum(s2) * (1.0f / D) + RMS_EPS);
            if (rstd_out) { if (lane == 0) rstd_out[m] = rx; continue; }
            const GAS f32x4* gq = (const GAS f32x4*)g_pre + 2 * lane;
#pragma unroll
            for (int j = 0; j < 8; ++j) { const f32x4 g0 = gq[128 * j], g1 = gq[128 * j + 1]; float hv[8];
#pragma unroll
                for (int e = 0; e < 8; ++e) hv[e] = x[j][e] * rx * ((e < 4) ? g0[e] : g1[e - 4]);
                if constexpr (H8) {
#pragma unroll
                    for (int e = 0; e < 8; ++e) hv[e] = __builtin_amdgcn_fmed3f(hv[e] * 8.0f, -448.0f, 448.0f);
                    int w0 = __builtin_amdgcn_cvt_pk_fp8_f32(hv[0], hv[1], 0, false); w0 = __builtin_amdgcn_cvt_pk_fp8_f32(hv[2], hv[3], w0, true);
                    int w1 = __builtin_amdgcn_cvt_pk_fp8_f32(hv[4], hv[5], 0, false); w1 = __builtin_amdgcn_cvt_pk_fp8_f32(hv[6], hv[7], w1, true);
                    ((GAS u32x2*)((unsigned char*)H + (size_t)m * D) + lane)[64 * j] = (u32x2){(unsigned)w0, (unsigned)w1};
                } else { u32x4 w; w.x = pk2(hv[0], hv[1]); w.y = pk2(hv[2], hv[3]); w.z = pk2(hv[4], hv[5]); w.w = pk2(hv[6], hv[7]); ((GAS u32x4*)(H + (size_t)m * D) + lane)[64 * j] = w; } }
        }
    }
}

DI float fox_logsig(float z) { return (z >= 0.f) ? -log1pf(expf(-z)) : (z - log1pf(expf(z))); }
DI void fox_cumsum_phase(CArgs& a, LAS unsigned char* lds, int wave, int lane) {
    const float* FL = (const float*)(a.ws + WS_FL); float* C = (float*)(a.ws + WS_C);
    LAS float* red = (LAS float*)lds;
    const int tid_ = wave * 64 + lane;
    for (int u = blockIdx.x; u < BATCH * FOXH * 4; u += gridDim.x) {
        const int bh = u >> 2, seg = u & 3, b = bh >> 4, h = bh & 15; const float bias = a.in[I_FBIAS][h];
        const float* fl = FL + (size_t)b * SEQ * 16 + h;
        const float own = fox_logsig(fl[(size_t)(512 * seg + tid_) * 16] + bias);
        float before = 0.f;
        for (int s = 0; s < seg; ++s) before += fox_logsig(fl[(size_t)(512 * s + tid_) * 16] + bias);
        float incl = own;
#pragma unroll
        for (int o = 1; o < 64; o <<= 1) { const float t = __shfl_up(incl, o); if (lane >= o) incl += t; }
        float bsum = before;
#pragma unroll
        for (int o = 32; o > 0; o >>= 1) bsum += __shfl_xor(bsum, o);
        __syncthreads();
        if (lane == 63) red[wave] = incl;
        if (lane == 0) red[8 + wave] = bsum;
        __syncthreads();
        float off = 0.f;
#pragma unroll
        for (int w = 0; w < 8; ++w) { off += red[8 + w]; if (w < wave) off += red[w]; }
        C[(size_t)bh * SEQ + 512 * seg + tid_] = (off + incl) * LOG2E;
    }
}
DI void lora_act_phase(CArgs& a, int wave, int lane) {
    const int gw = blockIdx.x * NWAVES + wave, NGW = gridDim.x * NWAVES;
    const bf16* PROJ = (const bf16*)(a.ws + WS_BIG); bf16* AL = (bf16*)(a.ws + WS_ALORA); const float* mu = a.in[I_MU] + 6144;
    for (int m = gw; m < M; m += NGW) {
        const bool has_prev = (m & (SEQ - 1)) != 0; const bf16* cur = PROJ + (size_t)m * NIN + PC_LORA; bf16* o = AL + (size_t)m * ALD;
        if (lane < 56) {
            const int j = 8 * lane; const u32x4 c4 = *(const GAS u32x4*)(cur + j); u32x4 p4 = (u32x4){0u, 0u, 0u, 0u}; if (has_prev) p4 = *(const GAS u32x4*)(cur + j - NIN);
            const f32x4 m0 = *(const GAS f32x4*)(mu + j), m1 = *(const GAS f32x4*)(mu + j + 4);
            float z[8];
#pragma unroll
            for (int e = 0; e < 4; ++e) { const float c0 = bflo(c4[e]), c1 = bfhi(c4[e]), p0 = bflo(p4[e]), p1 = bfhi(p4[e]); const float mm0 = (e < 2) ? m0[2 * e] : m1[2 * e - 4], mm1 = (e < 2) ? m0[2 * e + 1] : m1[2 * e - 3];
                z[2 * e] = c0 + mm0 * (p0 - c0); z[2 * e + 1] = c1 + mm1 * (p1 - c1); }
            int dst;
            if (lane < 12) { dst = j;
#pragma unroll
                for (int e = 0; e < 8; ++e) z[e] = tanhf(z[e]); }
            else if (lane < 24) dst = 256 + (j - 96);
            else { dst = 512 + (j - 192);
#pragma unroll
                for (int e = 0; e < 8; ++e) z[e] = 1.0f / (1.0f + __expf(-z[e])); }
            u32x4 w; w.x = pk2(z[0], z[1]); w.y = pk2(z[2], z[3]); w.z = pk2(z[4], z[5]); w.w = pk2(z[6], z[7]); *(GAS u32x4*)(o + dst) = w;
        }
        if (lane < 40) { const int dst = (lane < 20) ? (96 + 8 * lane) : (352 + 8 * (lane - 20)); *(GAS u32x4*)(o + dst) = (u32x4){0u, 0u, 0u, 0u}; }
    }
}
DI float lane8_sum(float x) {
    x += __builtin_bit_cast(float, __builtin_amdgcn_update_dpp(0, __builtin_bit_cast(int, x), 0xB1, 0xf, 0xf, false));
    x += __builtin_bit_cast(float, __builtin_amdgcn_update_dpp(0, __builtin_bit_cast(int, x), 0x4E, 0xf, 0xf, false));
    x += __builtin_bit_cast(float, __builtin_amdgcn_update_dpp(0, __builtin_bit_cast(int, x), 0x141, 0xf, 0xf, false));
    return x;
}
DI void rwkv_post_phase(CArgs& a, int wave, int lane) {
    const int gw = blockIdx.x * NWAVES + wave, NGW = gridDim.x * NWAVES;
    const float* YR = (const float*)(a.ws + WS_YR); const bf16* PROJ = (const bf16*)(a.ws + WS_BIG); const bf16* G_ = (const bf16*)(a.ws + WS_G); const float* BON = (const float*)(a.ws + WS_BON);
    bf16* MIX = (bf16*)(a.ws + WS_ACT2);
    for (int task = gw; task < M * 4; task += NGW) {
        const int m = task >> 2, c = (task & 3) * 512 + 8 * lane, h = c >> 6; const bool has_prev = (m & (SEQ - 1)) != 0;
        const f32x4 y0 = *(const GAS f32x4*)(YR + (size_t)m * RW + c), y1 = *(const GAS f32x4*)(YR + (size_t)m * RW + c + 4);
        const bf16* pv = PROJ + (size_t)m * NIN + PC_RKV + 4096 + c;
        const u32x4 vc = *(const GAS u32x4*)pv; u32x4 vp = (u32x4){0u, 0u, 0u, 0u}; if (has_prev) vp = *(const GAS u32x4*)(pv - NIN);
        const u32x4 gg = *(const GAS u32x4*)(G_ + (size_t)m * RW + c);
        const float bon = BON[(size_t)m * RH + h];
        const f32x4 mu0 = *(const GAS f32x4*)(a.in[I_MU] + 4096 + c), mu1 = *(const GAS f32x4*)(a.in[I_MU] + 4096 + c + 4);
        const f32x4 lw0 = *(const GAS f32x4*)(a.in[I_LNW] + c), lw1 = *(const GAS f32x4*)(a.in[I_LNW] + c + 4), lb0 = *(const GAS f32x4*)(a.in[I_LNB] + c), lb1 = *(const GAS f32x4*)(a.in[I_LNB] + c + 4);
        float y[8] = {y0[0], y0[1], y0[2], y0[3], y1[0], y1[1], y1[2], y1[3]};
        float s = 0.f;
#pragma unroll
        for (int e = 0; e < 8; ++e) s += y[e];
        const float mean = lane8_sum(s) * (1.0f / 64.0f); float q = 0.f;
#pragma unroll
        for (int e = 0; e < 8; ++e) { y[e] -= mean; q += y[e] * y[e]; }
        const float rstd = 1.0f / sqrtf(lane8_sum(q) * (1.0f / 64.0f) + GN_EPS);
        float o[8];
#pragma unroll
        for (int e = 0; e < 8; ++e) { const float vcur = (e & 1) ? bfhi(vc[e >> 1]) : bflo(vc[e >> 1]), vprev = (e & 1) ? bfhi(vp[e >> 1]) : bflo(vp[e >> 1]);
            const float mue = (e < 4) ? mu0[e] : mu1[e - 4], lwe = (e < 4) ? lw0[e] : lw1[e - 4], lbe = (e < 4) ? lb0[e] : lb1[e - 4];
            const float v = vcur + mue * (vprev - vcur); const float ge = (e & 1) ? bfhi(gg[e >> 1]) : bflo(gg[e >> 1]);
            o[e] = (y[e] * rstd * lwe + lbe + bon * v) * ge; }
        u32x4 w; w.x = pk2(o[0], o[1]); w.y = pk2(o[2], o[3]); w.z = pk2(o[4], o[5]); w.w = pk2(o[6], o[7]);
        *(GAS u32x4*)(MIX + (size_t)m * D + RW + c) = w;
    }
}

DI float row16_sum(float x) {
    x += __builtin_bit_cast(float, __builtin_amdgcn_update_dpp(0, __builtin_bit_cast(int, x), 0x128, 0xf, 0xf, false));
    x += __builtin_bit_cast(float, __builtin_amdgcn_update_dpp(0, __builtin_bit_cast(int, x), 0x124, 0xf, 0xf, false));
    x += __builtin_bit_cast(float, __builtin_amdgcn_update_dpp(0, __builtin_bit_cast(int, x), 0x122, 0xf, 0xf, false));
    x += __builtin_bit_cast(float, __builtin_amdgcn_update_dpp(0, __builtin_bit_cast(int, x), 0x121, 0xf, 0xf, false));
    return x;
}
DI float row8_sum(float x) {
    x += __builtin_bit_cast(float, __builtin_amdgcn_update_dpp(0, __builtin_bit_cast(int, x), 0x141, 0xf, 0xf, false));
    x += __builtin_bit_cast(float, __builtin_amdgcn_update_dpp(0, __builtin_bit_cast(int, x), 0x1B, 0xf, 0xf, false));
    x += __builtin_bit_cast(float, __builtin_amdgcn_update_dpp(0, __builtin_bit_cast(int, x), 0xB1, 0xf, 0xf, false));
    return x;
}
constexpr int SC_T = 16;
constexpr int SC_R = 0, SC_W = 4096, SC_KM = 8192, SC_KK = 12288, SC_KKA = 16384, SC_V = 20480, SC_BUF = 22528 + 512;
constexpr int SC_YB = 3 * SC_BUF, SC_CVT = 73728;
static_assert(SC_YB + 2 * 2048 <= SC_CVT && SC_CVT + 4 * 16384 <= MISC_OFF, "scan LDS map");
DI void fox4_run(CArgs& a, int u, LAS unsigned char* lds, volatile LAS unsigned* cnt, unsigned& target, int w4, int lane);
DI void scan_unit(CArgs& a, int unit, bool do_cvt, LAS unsigned char* lds, volatile LAS unsigned* cntw, int tid, int wave, int lane) {
    const unsigned cbase = *cntw; const unsigned cbase2 = cntw[4];
    __syncthreads();
    if (wave >= 4) {
        if (do_cvt) { LAS float* scr = (LAS float*)(lds + SC_CVT + (wave - 4) * 16384); const int cw = blockIdx.x * 4 + (wave - 4), NCW = gridDim.x * 4;
            for (int it = CVT_EARLY + (gridDim.x == 256 ? 2 * CVT_TAIL : 0) + cw; it < CVT_NITEMS; it += NCW) { CvtJob J; int local; if (cvt_pick(a, it, J, local)) cvt_item(J, local, scr, lane); }
            __builtin_amdgcn_s_setprio(FOX_PRIO); unsigned tgt2 = cbase2; for (int fu = blockIdx.x; fu < 256; fu += gridDim.x) fox4_run(a, fu, lds, cntw + 4, tgt2, wave - 4, lane); __builtin_amdgcn_s_setprio(0); }
    } else {
    __builtin_amdgcn_s_setprio(3);
    const int half = unit & 1, bh = unit >> 1, b = bh >> 5, h = bh & 31;
    const bf16* PROJ = (const bf16*)(a.ws + WS_BIG); const float* AA = (const float*)(a.ws + WS_AA); const float* WD = (const float*)(a.ws + WS_WDEC);
    float* YR = (float*)(a.ws + WS_YR); float* BON = (float*)(a.ws + WS_BON);
    const int rp = lane >> 4, g = lane & 15, rowA = 8 * wave + 2 * rp;
    unsigned target = cbase;
#define SC_ARRIVE() do { asm volatile("s_waitcnt lgkmcnt(0)" ::: "memory"); if (lane == 0) __hip_atomic_fetch_add((LAS unsigned*)cntw, 1u, __ATOMIC_RELAXED, __HIP_MEMORY_SCOPE_WORKGROUP); target += 4u; } while (0)
#define SC_WAIT() do { while ((int)(__hip_atomic_load((LAS unsigned*)cntw, __ATOMIC_RELAXED, __HIP_MEMORY_SCOPE_WORKGROUP) - target) < 0) { } asm volatile("" ::: "memory"); } while (0)
#define SC_BAR() do { asm volatile("s_waitcnt lgkmcnt(0)" ::: "memory"); if (lane == 0) __hip_atomic_fetch_add((LAS unsigned*)cntw, 1u, __ATOMIC_RELAXED, __HIP_MEMORY_SCOPE_WORKGROUP); target += 4u; \
        while ((int)(__hip_atomic_load((LAS unsigned*)cntw, __ATOMIC_RELAXED, __HIP_MEMORY_SCOPE_WORKGROUP) - target) < 0) { } asm volatile("" ::: "memory"); } while (0)
    const int st = tid >> 4, c4 = h * 64 + 4 * g;
    const bf16* gP = PROJ + (size_t)(b * SEQ + st) * NIN + PC_RKV + c4; const float* gA = AA + (size_t)(b * SEQ + st) * RW + c4; const float* gW = WD + (size_t)(b * SEQ + st) * RW + c4;
    const f32x4 mur = *(const GAS f32x4*)(a.in[I_MU] + c4), muk = *(const GAS f32x4*)(a.in[I_MU] + 2048 + c4), muv = *(const GAS f32x4*)(a.in[I_MU] + 4096 + c4);
    const f32x4 pkk = *(const GAS f32x4*)(a.in[I_KK] + c4), pka = *(const GAS f32x4*)(a.in[I_KA] + c4), prk = *(const GAS f32x4*)(a.in[I_RK] + c4);
    u32x2 rc, kc, vc, rp_, kp, vp; f32x4 av, wv;
#define SC_LOAD(ck) do { const size_t _o = (size_t)(ck) * SC_T; const bf16* _p = gP + _o * NIN; rc = *(const GAS u32x2*)_p; kc = *(const GAS u32x2*)(_p + 2048); vc = *(const GAS u32x2*)(_p + 4096); \
        if ((ck) * SC_T + st > 0) { rp_ = *(const GAS u32x2*)(_p - NIN); kp = *(const GAS u32x2*)(_p - NIN + 2048); vp = *(const GAS u32x2*)(_p - NIN + 4096); } else { rp_ = (u32x2){0u, 0u}; kp = rp_; vp = rp_; } \
        av = *(const GAS f32x4*)(gA + _o * RW); wv = *(const GAS f32x4*)(gW + _o * RW); } while (0)
#define SC_UNP(u) ((f32x4){bflo((u).x), bfhi((u).x), bflo((u).y), bfhi((u).y)})
#define SC_STORE(bufo, ck) do { \
        f32x4 r = SC_UNP(rc), k = SC_UNP(kc), v = SC_UNP(vc); r = r + mur * (SC_UNP(rp_) - r); k = k + muk * (SC_UNP(kp) - k); v = v + muv * (SC_UNP(vp) - v); \
        f32x4 kk = k * pkk; const float n2 = row16_sum((kk.x * kk.x + kk.y * kk.y) + (kk.z * kk.z + kk.w * kk.w)); kk = kk * __builtin_amdgcn_rsqf(fmaxf(n2, 1e-24f)); \
        const f32x4 km = k * (1.0f + (av - 1.0f) * pka); const f32x4 rk = r * km * prk; const float bon = row16_sum((rk.x + rk.y) + (rk.z + rk.w)); \
        LAS unsigned char* _b = lds + (bufo) + st * 256 + g * 16; \
        *(LAS f32x4*)(_b + SC_R) = r; *(LAS f32x4*)(_b + SC_W) = wv; *(LAS f32x4*)(_b + SC_KM) = km; *(LAS f32x4*)(_b + SC_KK) = kk; *(LAS f32x4*)(_b + SC_KKA) = kk * av; \
        if ((g >> 3) == half) *(LAS f32x4*)(lds + (bufo) + SC_V + st * 128 + (g & 7) * 16) = v; \
        if (g == 0 && half == 0) BON[(size_t)(b * SEQ + (ck) * SC_T + st) * RH + h] = bon; } while (0)
    const int rq = lane >> 3, g8 = lane & 7, rowQ = 8 * wave + rq;
    float s0 = 0.f, s1 = 0.f, s2 = 0.f, s3 = 0.f, s4 = 0.f, s5 = 0.f, s6 = 0.f, s7 = 0.f;
    constexpr int NCH = SEQ / SC_T;
    SC_LOAD(0); SC_STORE(0, 0); SC_LOAD(1);
    SC_BAR();
    int bcur = 0;
    for (int ck = 0; ck < NCH; ++ck) {
        const int bo = bcur * SC_BUF; const int bnext = (bcur == 2) ? 0 : bcur + 1;
        if (ck + 1 < NCH) { SC_STORE(bnext * SC_BUF, ck + 1); if (ck + 2 < NCH) SC_LOAD(ck + 2); }
        SC_ARRIVE();
        const LAS unsigned char* bp = lds + bo + g8 * 32; const LAS unsigned char* vp_ = lds + bo + SC_V + rowQ * 4; LAS unsigned char* yb = lds + SC_YB + (ck & 1) * 2048 + rowQ * 4;
#define SC_LD(P, t) do { P##kk0 = *(const LAS f32x4*)(bp + SC_KK + (t) * 256); P##kk1 = *(const LAS f32x4*)(bp + SC_KK + (t) * 256 + 16); P##w0 = *(const LAS f32x4*)(bp + SC_W + (t) * 256); P##w1 = *(const LAS f32x4*)(bp + SC_W + (t) * 256 + 16); \
        P##ka0 = *(const LAS f32x4*)(bp + SC_KKA + (t) * 256); P##ka1 = *(const LAS f32x4*)(bp + SC_KKA + (t) * 256 + 16); P##km0 = *(const LAS f32x4*)(bp + SC_KM + (t) * 256); P##km1 = *(const LAS f32x4*)(bp + SC_KM + (t) * 256 + 16); \
        P##r0 = *(const LAS f32x4*)(bp + SC_R + (t) * 256); P##r1 = *(const LAS f32x4*)(bp + SC_R + (t) * 256 + 16); P##v = *(const LAS float*)(vp_ + (t) * 128); } while (0)
#define SC_MUL(d, x, y) asm("v_mul_f32 %0, %1, %2" : "=v"(d) : "v"(x), "v"(y))
#define SC_FMA(d, x, y, z) asm("v_fma_f32 %0, %1, %2, %3" : "=v"(d) : "v"(x), "v"(y), "v"(z))
#define SC_FNMA(d, x, y, z) asm("v_fma_f32 %0, -%1, %2, %3" : "=v"(d) : "v"(x), "v"(y), "v"(z))
#define SC_RED1(P) asm volatile( \
        "v_add_f32 %[d], %[m0], %[m1]\n\tv_mul_f32 %[t0], %[k0], %[v]\n\tv_mul_f32 %[t1], %[k1], %[v]\n\tv_mul_f32 %[t2], %[k2], %[v]\n\tv_mul_f32 %[t3], %[k3], %[v]\n\t" \
        "v_add_f32_dpp %[d], %[d], %[d] row_half_mirror row_mask:0xf bank_mask:0xf\n\tv_mul_f32 %[t4], %[k4], %[v]\n\tv_mul_f32 %[t5], %[k5], %[v]\n\t" \
        "v_add_f32_dpp %[d], %[d], %[d] quad_perm:[3,2,1,0] row_mask:0xf bank_mask:0xf\n\tv_mul_f32 %[t6], %[k6], %[v]\n\tv_mul_f32 %[t7], %[k7], %[v]\n\t" \
        "v_add_f32_dpp %[d], %[d], %[d] quad_perm:[1,0,3,2] row_mask:0xf bank_mask:0xf" \
        : [d] "=&v"(dA), [t0] "=&v"(t0), [t1] "=&v"(t1), [t2] "=&v"(t2), [t3] "=&v"(t3), [t4] "=&v"(t4), [t5] "=&v"(t5), [t6] "=&v"(t6), [t7] "=&v"(t7) \
        : [m0] "v"(m0), [m1] "v"(m1), [v] "v"(P##v), [k0] "v"(P##km0.x), [k1] "v"(P##km0.y), [k2] "v"(P##km0.z), [k3] "v"(P##km0.w), [k4] "v"(P##km1.x), [k5] "v"(P##km1.y), [k6] "v"(P##km1.z), [k7] "v"(P##km1.w))
#define SC_RED2(N) asm volatile( \
        "v_add_f32 %[y], %[a0], %[a1]\n\tv_mul_f32 %[n0], %[s0], %[q0]\n\tv_mul_f32 %[n1], %[s4], %[q4]\n\t" \
        "v_add_f32_dpp %[y], %[y], %[y] row_half_mirror row_mask:0xf bank_mask:0xf\n\tv_fma_f32 %[n0], %[s1], %[q1], %[n0]\n\tv_fma_f32 %[n1], %[s5], %[q5], %[n1]\n\t" \
        "v_add_f32_dpp %[y], %[y], %[y] quad_perm:[3,2,1,0] row_mask:0xf bank_mask:0xf\n\tv_fma_f32 %[n0], %[s2], %[q2], %[n0]\n\tv_fma_f32 %[n1], %[s6], %[q6], %[n1]\n\t" \
        "v_add_f32_dpp %[y], %[y], %[y] quad_perm:[1,0,3,2] row_mask:0xf bank_mask:0xf\n\tv_fma_f32 %[n0], %[s3], %[q3], %[n0]\n\tv_fma_f32 %[n1], %[s7], %[q7], %[n1]" \
        : [y] "=&v"(yA), [n0] "=&v"(m0), [n1] "=&v"(m1) \
        : [a0] "v"(y0), [a1] "v"(y1), [s0] "v"(s0), [s1] "v"(s1), [s2] "v"(s2), [s3] "v"(s3), [s4] "v"(s4), [s5] "v"(s5), [s6] "v"(s6), [s7] "v"(s7), \
          [q0] "v"(N##kk0.x), [q1] "v"(N##kk0.y), [q2] "v"(N##kk0.z), [q3] "v"(N##kk0.w), [q4] "v"(N##kk1.x), [q5] "v"(N##kk1.y), [q6] "v"(N##kk1.z), [q7] "v"(N##kk1.w))
#define SC_RED2L() asm volatile( \
        "v_add_f32 %[y], %[a0], %[a1]\n\ts_nop 1\n\tv_add_f32_dpp %[y], %[y], %[y] row_half_mirror row_mask:0xf bank_mask:0xf\n\ts_nop 1\n\t" \
        "v_add_f32_dpp %[y], %[y], %[y] quad_perm:[3,2,1,0] row_mask:0xf bank_mask:0xf\n\ts_nop 1\n\tv_add_f32_dpp %[y], %[y], %[y] quad_perm:[1,0,3,2] row_mask:0xf bank_mask:0xf" \
        : [y] "=&v"(yA) : [a0] "v"(y0), [a1] "v"(y1))
#define SC_PART(P) do { SC_MUL(m0, s0, P##kk0.x); SC_MUL(m1, s4, P##kk1.x); SC_FMA(m0, s1, P##kk0.y, m0); SC_FMA(m1, s5, P##kk1.y, m1); \
        SC_FMA(m0, s2, P##kk0.z, m0); SC_FMA(m1, s6, P##kk1.z, m1); SC_FMA(m0, s3, P##kk0.w, m0); SC_FMA(m1, s7, P##kk1.w, m1); } while (0)
#define SC_UPD1(P) asm volatile( \
        "v_fma_f32 %[s0], %[s0], %[w0], %[t0]\n\tv_fma_f32 %[s1], %[s1], %[w1], %[t1]\n\tv_fma_f32 %[s2], %[s2], %[w2], %[t2]\n\tv_fma_f32 %[s3], %[s3], %[w3], %[t3]\n\t" \
        "v_fma_f32 %[s4], %[s4], %[w4], %[t4]\n\tv_fma_f32 %[s5], %[s5], %[w5], %[t5]\n\tv_fma_f32 %[s6], %[s6], %[w6], %[t6]\n\tv_fma_f32 %[s7], %[s7], %[w7], %[t7]" \
        : [s0] "+v"(s0), [s1] "+v"(s1), [s2] "+v"(s2), [s3] "+v"(s3), [s4] "+v"(s4), [s5] "+v"(s5), [s6] "+v"(s6), [s7] "+v"(s7) \
        : [t0] "v"(t0), [t1] "v"(t1), [t2] "v"(t2), [t3] "v"(t3), [t4] "v"(t4), [t5] "v"(t5), [t6] "v"(t6), [t7] "v"(t7), \
          [w0] "v"(P##w0.x), [w1] "v"(P##w0.y), [w2] "v"(P##w0.z), [w3] "v"(P##w0.w), [w4] "v"(P##w1.x), [w5] "v"(P##w1.y), [w6] "v"(P##w1.z), [w7] "v"(P##w1.w))
#define SC_UPD2(P) asm volatile( \
        "v_fma_f32 %[s0], -%[d], %[a0], %[s0]\n\tv_fma_f32 %[s4], -%[d], %[a4], %[s4]\n\tv_fma_f32 %[s1], -%[d], %[a1], %[s1]\n\tv_fma_f32 %[s5], -%[d], %[a5], %[s5]\n\t" \
        "v_fma_f32 %[s2], -%[d], %[a2], %[s2]\n\tv_fma_f32 %[s6], -%[d], %[a6], %[s6]\n\tv_fma_f32 %[s3], -%[d], %[a3], %[s3]\n\tv_fma_f32 %[s7], -%[d], %[a7], %[s7]\n\t" \
        "v_mul_f32 %[y0], %[s0], %[r0]\n\tv_mul_f32 %[y1], %[s4], %[r4]\n\tv_fma_f32 %[y0], %[s1], %[r1], %[y0]\n\tv_fma_f32 %[y1], %[s5], %[r5], %[y1]\n\t" \
        "v_fma_f32 %[y0], %[s2], %[r2], %[y0]\n\tv_fma_f32 %[y1], %[s6], %[r6], %[y1]\n\tv_fma_f32 %[y0], %[s3], %[r3], %[y0]\n\tv_fma_f32 %[y1], %[s7], %[r7], %[y1]" \
        : [s0] "+v"(s0), [s1] "+v"(s1), [s2] "+v"(s2), [s3] "+v"(s3), [s4] "+v"(s4), [s5] "+v"(s5), [s6] "+v"(s6), [s7] "+v"(s7), [y0] "=&v"(y0), [y1] "=&v"(y1) \
        : [d] "v"(dA), [a0] "v"(P##ka0.x), [a1] "v"(P##ka0.y), [a2] "v"(P##ka0.z), [a3] "v"(P##ka0.w), [a4] "v"(P##ka1.x), [a5] "v"(P##ka1.y), [a6] "v"(P##ka1.z), [a7] "v"(P##ka1.w), \
          [r0] "v"(P##r0.x), [r1] "v"(P##r0.y), [r2] "v"(P##r0.z), [r3] "v"(P##r0.w), [r4] "v"(P##r1.x), [r5] "v"(P##r1.y), [r6] "v"(P##r1.z), [r7] "v"(P##r1.w))
#define SC_BODY(P) float dA, t0, t1, t2, t3, t4, t5, t6, t7, y0, y1, yA; \
        SC_RED1(P); SC_UPD1(P); SC_UPD2(P);
#define SC_STEP_M(P, N, t) do { SC_BODY(P) SC_RED2(N); *(LAS float*)(yb + (t) * 128) = yA; } while (0)
#define SC_STEP_L(P, t) do { SC_BODY(P) SC_RED2L(); *(LAS float*)(yb + (t) * 128) = yA; } while (0)
        f32x4 p0kk0, p0kk1, p0w0, p0w1, p0ka0, p0ka1, p0km0, p0km1, p0r0, p0r1, p1kk0, p1kk1, p1w0, p1w1, p1ka0, p1ka1, p1km0, p1km1, p1r0, p1r1; float p0v, p1v, m0, m1;
        SC_LD(p0, 0);
        SC_PART(p0);
#pragma unroll 2
        for (int t = 0; t < SC_T - 2; t += 2) {
            SC_LD(p1, t + 1);
            SC_STEP_M(p0, p1, t);
            SC_LD(p0, t + 2);
            SC_STEP_M(p1, p0, t + 1);
        }
        SC_LD(p1, SC_T - 1);
        SC_STEP_M(p0, p1, SC_T - 2);
        SC_STEP_L(p1, SC_T - 1);
        asm volatile("s_waitcnt lgkmcnt(0)" ::: "memory");
        if (lane < 32) { const int sy = lane >> 1, r4i = 8 * wave + 4 * (lane & 1);
            *(GAS f32x4*)(YR + (size_t)(b * SEQ + ck * SC_T + sy) * RW + h * 64 + half * 32 + r4i) = *(const LAS f32x4*)(lds + SC_YB + (ck & 1) * 2048 + sy * 128 + r4i * 4); }
        SC_WAIT();
        bcur = bnext;
    }
#undef SC_BAR
#undef SC_ARRIVE
#undef SC_WAIT
#undef SC_LOAD
#undef SC_UNP
#undef SC_STORE
#undef SC_LD
#undef SC_MUL
#undef SC_FMA
#undef SC_FNMA
#undef SC_RED1
#undef SC_RED2
#undef SC_RED2L
#undef SC_PART
#undef SC_BODY
#undef SC_UPD1
#undef SC_UPD2
#undef SC_STEP_M
#undef SC_STEP_L
    __builtin_amdgcn_s_setprio(0);
    }
    __syncthreads();
}

constexpr int FX_KP = 272, FX_VP = 320, FX_K0 = 0, FX_KB = 64 * FX_KP, FX_V0 = 2 * FX_KB, FX_VB = 64 * FX_VP, FX_C0 = FX_V0 + 2 * FX_VB, FX_CB = 256;
DI void fox_block(const bf16* PROJ, const float* Cb, bf16* MIX, int b, int h, int xq, LAS unsigned char* lds, int tid, int wave, int lane) {
    const int c = lane & 31, hh = lane >> 5, i16 = lane & 15, q4 = i16 >> 2, p4 = i16 & 3, blk = (lane >> 4) & 1;
    const int qbase = xq * 256 + 32 * wave, q_abs = qbase + c;
    const size_t rowq = (size_t)(b * SEQ + q_abs);
    bf16x8 qf[8];
#pragma unroll
    for (int ks = 0; ks < 8; ++ks) qf[ks] = *(const GAS bf16x8*)(PROJ + rowq * NIN + h * FOXD + 16 * ks + 8 * hh);
    const float cq2 = Cb[q_abs];
    f32x16 o[4];
#pragma unroll
    for (int d = 0; d < 4; ++d)
#pragma unroll
        for (int i = 0; i < 16; ++i) o[d][i] = 0.f;
    float mrun = -1e30f, lrun = 0.f;
    const int ntiles = 4 * (xq + 1);
    const int key0 = tid >> 4, c16 = tid & 15;
    const bf16* kg = PROJ + (size_t)(b * SEQ + key0) * NIN + 2048 + h * FOXD + 8 * c16;
    const int kl = key0 * FX_KP + c16 * 16, vl = key0 * FX_VP + c16 * 16;
    u32x4 kr0, kr1, vr0, vr1; float ckr = 0.f;
#define FX_LOAD(j) do { const bf16* _p = kg + (size_t)(j) * 64 * NIN; kr0 = *(const GAS u32x4*)_p; kr1 = *(const GAS u32x4*)(_p + (size_t)32 * NIN); vr0 = *(const GAS u32x4*)(_p + 2048); vr1 = *(const GAS u32x4*)(_p + (size_t)32 * NIN + 2048); \
        if (tid < 64) ckr = Cb[(j) * 64 + tid]; } while (0)
#define FX_STORE(bi) do { *(LAS u32x4*)(lds + FX_K0 + (bi) * FX_KB + kl) = kr0; *(LAS u32x4*)(lds + FX_K0 + (bi) * FX_KB + kl + 32 * FX_KP) = kr1; \
        *(LAS u32x4*)(lds + FX_V0 + (bi) * FX_VB + vl) = vr0; *(LAS u32x4*)(lds + FX_V0 + (bi) * FX_VB + vl + 32 * FX_VP) = vr1; if (tid < 64) *(LAS float*)(lds + FX_C0 + (bi) * FX_CB + tid * 4) = ckr; } while (0)
    FX_LOAD(0); FX_STORE(0);
    __syncthreads();
    const float C2S = 0.08838834764831845f * LOG2E;
    const int kbase = c * FX_KP + hh * 16, vbase = (4 * hh + q4) * FX_VP + blk * 32 + p4 * 8;
    for (int j = 0; j < ntiles; ++j) {
        const int bi = j & 1;
        if (j + 1 < ntiles) FX_LOAD(j + 1);
        if (64 * j <= qbase + 31) {
            const LAS unsigned char* KL = lds + FX_K0 + bi * FX_KB + kbase; const LAS unsigned char* VL = lds + FX_V0 + bi * FX_VB + vbase; const LAS unsigned char* CL = lds + FX_C0 + bi * FX_CB + hh * 16;
            f32x16 p0, p1;
#pragma unroll
            for (int i = 0; i < 16; ++i) { p0[i] = 0.f; p1[i] = 0.f; }
#pragma unroll
            for (int ks = 0; ks < 8; ++ks) { const bf16x8 a0 = *(const LAS bf16x8*)(KL + ks * 32), a1 = *(const LAS bf16x8*)(KL + 32 * FX_KP + ks * 32);
                p0 = __builtin_amdgcn_mfma_f32_32x32x16_bf16(a0, qf[ks], p0, 0, 0, 0); p1 = __builtin_amdgcn_mfma_f32_32x32x16_bf16(a1, qf[ks], p1, 0, 0, 0); }
#pragma unroll
            for (int gI = 0; gI < 4; ++gI) { const f32x4 c0 = *(const LAS f32x4*)(CL + gI * 32), c1 = *(const LAS f32x4*)(CL + 128 + gI * 32);
#pragma unroll
                for (int jj = 0; jj < 4; ++jj) { p0[4 * gI + jj] = fmaf(p0[4 * gI + jj], C2S, -c0[jj]); p1[4 * gI + jj] = fmaf(p1[4 * gI + jj], C2S, -c1[jj]); } }
            if (64 * j + 63 > qbase) {
                const float NEG = -__builtin_inff();
#pragma unroll
                for (int i = 0; i < 16; ++i) { const int key = 64 * j + (i & 3) + 8 * (i >> 2) + 4 * hh; if (key > q_abs) p0[i] = NEG; if (key + 32 > q_abs) p1[i] = NEG; }
            }
            float mt = fmaxf(p0[0], p1[0]);
#pragma unroll
            for (int i = 1; i < 16; ++i) mt = fmaxf(mt, fmaxf(p0[i], p1[i]));
            mt = fmaxf(mt, __shfl_xor(mt, 32));
            const float mn = fmaxf(mrun, mt), alpha = __builtin_amdgcn_exp2f(mrun - mn); mrun = mn;
            float ls = 0.f;
#pragma unroll
            for (int i = 0; i < 16; ++i) { p0[i] = __builtin_amdgcn_exp2f(p0[i] - mn); p1[i] = __builtin_amdgcn_exp2f(p1[i] - mn); ls += p0[i] + p1[i]; }
            lrun = lrun * alpha + ls;
#pragma unroll
            for (int d = 0; d < 4; ++d)
#pragma unroll
                for (int i = 0; i < 16; ++i) o[d][i] *= alpha;
            bf16x8 pf[2][2];
#pragma unroll
            for (int s = 0; s < 2; ++s) {
                u32x4 w0, w1; w0.x = pk2(p0[8 * s], p0[8 * s + 1]); w0.y = pk2(p0[8 * s + 2], p0[8 * s + 3]); w0.z = pk2(p0[8 * s + 4], p0[8 * s + 5]); w0.w = pk2(p0[8 * s + 6], p0[8 * s + 7]);
                w1.x = pk2(p1[8 * s], p1[8 * s + 1]); w1.y = pk2(p1[8 * s + 2], p1[8 * s + 3]); w1.z = pk2(p1[8 * s + 4], p1[8 * s + 5]); w1.w = pk2(p1[8 * s + 6], p1[8 * s + 7]);
                pf[0][s] = __builtin_bit_cast(bf16x8, w0); pf[1][s] = __builtin_bit_cast(bf16x8, w1); }
#pragma unroll
            for (int d = 0; d < 4; ++d)
#pragma unroll
                for (int kb = 0; kb < 2; ++kb)
#pragma unroll
                    for (int s = 0; s < 2; ++s) {
                        const s16x4 lo = __builtin_amdgcn_ds_read_tr16_b64_v4i16((LAS s16x4*)(VL + (32 * kb + 16 * s) * FX_VP + d * 64));
                        const s16x4 hi = __builtin_amdgcn_ds_read_tr16_b64_v4i16((LAS s16x4*)(VL + (32 * kb + 16 * s + 8) * FX_VP + d * 64));
                        const bf16x8 av = __builtin_shufflevector(lo, hi, 0, 1, 2, 3, 4, 5, 6, 7);
                        o[d] = __builtin_amdgcn_mfma_f32_32x32x16_bf16(av, pf[kb][s], o[d], 0, 0, 0); }
        }
        if (j + 1 < ntiles) FX_STORE(bi ^ 1);
        __syncthreads();
    }
#undef FX_LOAD
#undef FX_STORE
    const float ltot = lrun + __shfl_xor(lrun, 32); const float inv = 1.0f / ltot;
    bf16* orow = MIX + rowq * D + h * FOXD + 4 * hh;
#pragma unroll
    for (int d = 0; d < 4; ++d)
#pragma unroll
        for (int gI = 0; gI < 4; ++gI) { u32x2 w; w.x = pk2(o[d][4 * gI] * inv, o[d][4 * gI + 1] * inv); w.y = pk2(o[d][4 * gI + 2] * inv, o[d][4 * gI + 3] * inv);
            *(GAS u32x2*)(orow + 32 * d + 8 * gI) = w; }
}
DI void fox_phase(CArgs& a, LAS unsigned char* lds, int tid, int wave, int lane) {
    const bf16* PROJ = (const bf16*)(a.ws + WS_BIG); const float* C = (const float*)(a.ws + WS_C); bf16* MIX = (bf16*)(a.ws + WS_ACT2);
    for (int u = blockIdx.x; u < 256; u += gridDim.x) { const int bh = u >> 2, y = u & 3, b = bh >> 4, h = bh & 15;
        for (int s2 = 0; s2 < 2; ++s2) fox_block(PROJ, C + (size_t)bh * SEQ, MIX, b, h, s2 ? y : 7 - y, lds, tid, wave, lane); }
}

constexpr int F4_B = SC_CVT, F4_VP = 304, F4_K = F4_B, F4_V = F4_K + 64 * FX_KP, F4_C = F4_V + 64 * F4_VP, F4_Q = F4_C + 256, F4_QW = 32 * FX_KP;
static_assert(F4_Q + 4 * F4_QW <= MISC_OFF, "fox4 LDS map");
constexpr float FOX_THR = 16.0f;
DI void fox4_tile(const LAS unsigned char* KL, const LAS unsigned char* VL, const LAS unsigned char* CL, const LAS unsigned char* QL, int j, int qbase, int q_abs, int hh, float cq2, f32x16 (&o)[4], float& mrun, float& lrun) {
    const float C2S = 0.08838834764831845f * LOG2E;
    f32x16 p0, p1;
#pragma unroll
    for (int i = 0; i < 16; ++i) { p0[i] = 0.f; p1[i] = 0.f; }
#pragma unroll
    for (int ks = 0; ks < 8; ++ks) { const bf16x8 a0 = *(const LAS bf16x8*)(KL + ks * 32), a1 = *(const LAS bf16x8*)(KL + 32 * FX_KP + ks * 32), qk = *(const LAS bf16x8*)(QL + ks * 32);
        p0 = __builtin_amdgcn_mfma_f32_32x32x16_bf16(a0, qk, p0, 0, 0, 0); p1 = __builtin_amdgcn_mfma_f32_32x32x16_bf16(a1, qk, p1, 0, 0, 0); }
#pragma unroll
    for (int gI = 0; gI < 4; ++gI) { const f32x4 c0 = *(const LAS f32x4*)(CL + gI * 32), c1 = *(const LAS f32x4*)(CL + 128 + gI * 32);
#pragma unroll
        for (int jj = 0; jj < 4; ++jj) { p0[4 * gI + jj] = fmaf(p0[4 * gI + jj], C2S, -c0[jj]); p1[4 * gI + jj] = fmaf(p1[4 * gI + jj], C2S, -c1[jj]); } }
    if (64 * j + 63 > qbase) {
        const float NEG = -__builtin_inff();
#pragma unroll
        for (int i = 0; i < 16; ++i) { const int key = 64 * j + (i & 3) + 8 * (i >> 2) + 4 * hh; if (key > q_abs) p0[i] = NEG; if (key + 32 > q_abs) p1[i] = NEG; }
    }
    float mt = fmaxf(p0[0], p1[0]);
#pragma unroll
    for (int i = 1; i < 16; ++i) mt = fmaxf(mt, fmaxf(p0[i], p1[i]));
    mt = fmaxf(mt, __shfl_xor(mt, 32));
    const bool need = mt > mrun + FOX_THR;
    if (__builtin_amdgcn_ballot_w64(need)) {
        const float mn = need ? mt : mrun, alpha = __builtin_amdgcn_exp2f(mrun - mn); mrun = mn; lrun *= alpha;
#pragma unroll
        for (int d = 0; d < 4; ++d)
#pragma unroll
            for (int i = 0; i < 16; ++i) o[d][i] *= alpha;
    }
    const float mn = mrun;
    float ls = 0.f;
#pragma unroll
    for (int i = 0; i < 16; ++i) { p0[i] = __builtin_amdgcn_exp2f(p0[i] - mn); p1[i] = __builtin_amdgcn_exp2f(p1[i] - mn); ls += p0[i] + p1[i]; }
    lrun += ls;
    bf16x8 pf[2][2];
#pragma unroll
    for (int s = 0; s < 2; ++s) {
        u32x4 w0, w1; w0.x = pk2(p0[8 * s], p0[8 * s + 1]); w0.y = pk2(p0[8 * s + 2], p0[8 * s + 3]); w0.z = pk2(p0[8 * s + 4], p0[8 * s + 5]); w0.w = pk2(p0[8 * s + 6], p0[8 * s + 7]);
        w1.x = pk2(p1[8 * s], p1[8 * s + 1]); w1.y = pk2(p1[8 * s + 2], p1[8 * s + 3]); w1.z = pk2(p1[8 * s + 4], p1[8 * s + 5]); w1.w = pk2(p1[8 * s + 6], p1[8 * s + 7]);
        pf[0][s] = __builtin_bit_cast(bf16x8, w0); pf[1][s] = __builtin_bit_cast(bf16x8, w1); }
#pragma unroll
    for (int d = 0; d < 4; ++d)
#pragma unroll
        for (int kb = 0; kb < 2; ++kb)
#pragma unroll
            for (int s = 0; s < 2; ++s) {
                const s16x4 lo = __builtin_amdgcn_ds_read_tr16_b64_v4i16((LAS s16x4*)(VL + (32 * kb + 16 * s) * F4_VP + d * 64));
                const s16x4 hi = __builtin_amdgcn_ds_read_tr16_b64_v4i16((LAS s16x4*)(VL + (32 * kb + 16 * s + 8) * F4_VP + d * 64));
                const bf16x8 av = __builtin_shufflevector(lo, hi, 0, 1, 2, 3, 4, 5, 6, 7);
                o[d] = __builtin_amdgcn_mfma_f32_32x32x16_bf16(av, pf[kb][s], o[d], 0, 0, 0); }
}
DI void fox4_run(CArgs& a, int u, LAS unsigned char* lds, volatile LAS unsigned* cnt, unsigned& target, int w4, int lane) {
    const bf16* PROJ = (const bf16*)(a.ws + WS_BIG); bf16* MIX = (bf16*)(a.ws + WS_ACT2);
    const int bh = u >> 2, y = u & 3, b = bh >> 4, h = bh & 15; const float* Cb = (const float*)(a.ws + WS_C) + (size_t)bh * SEQ;
    const int t4 = w4 * 64 + lane;
#define F4_BAR() do { asm volatile("s_waitcnt lgkmcnt(0)" ::: "memory"); if (lane == 0) __hip_atomic_fetch_add((LAS unsigned*)cnt, 1u, __ATOMIC_RELAXED, __HIP_MEMORY_SCOPE_WORKGROUP); target += 4u; \
        while ((int)(__hip_atomic_load((LAS unsigned*)cnt, __ATOMIC_RELAXED, __HIP_MEMORY_SCOPE_WORKGROUP) - target) < 0) { } asm volatile("" ::: "memory"); } while (0)
    const int c = lane & 31, hh = lane >> 5, i16 = lane & 15, q4 = i16 >> 2, p4 = i16 & 3, blk = (lane >> 4) & 1;
    const int key0 = t4 >> 4, c16 = t4 & 15;
    const unsigned koff = (unsigned)(key0 * NIN + 8 * c16) * 2u;
    const int kl = key0 * FX_KP + c16 * 16, vl = key0 * F4_VP + c16 * 16;
    const int kbase = c * FX_KP + hh * 16, vbase = (4 * hh + q4) * F4_VP + blk * 32 + p4 * 8;
    LAS unsigned char* QLw = lds + F4_Q + w4 * F4_QW + c * FX_KP + hh * 16;
    F4_BAR();
#pragma unroll 1
    for (int bi = 0; bi < 4; ++bi) {
        const int xq = (bi == 0) ? 15 - y : (bi == 1) ? 8 + y : (bi == 2) ? 7 - y : y;
        const int qbase = xq * 128 + 32 * w4, q_abs = qbase + c; const size_t rowq = (size_t)(b * SEQ + q_abs);
#pragma unroll
        for (int ks = 0; ks < 8; ++ks) *(LAS bf16x8*)(QLw + ks * 32) = *(const GAS bf16x8*)(PROJ + rowq * NIN + h * FOXD + 16 * ks + 8 * hh);
        const float cq2 = Cb[q_abs];
        f32x16 o[4];
#pragma unroll
        for (int d = 0; d < 4; ++d)
#pragma unroll
            for (int i = 0; i < 16; ++i) o[d][i] = 0.f;
        float mrun = -1e30f, lrun = 0.f;
        const int ntiles = 2 * (xq + 1);
        u32x4 kr[4], vr[4]; float ckr = 0.f;
#define F4_LOAD(j) do { const char* _b = (const char*)PROJ + ((size_t)(b * SEQ + (j) * 64) * NIN + 2048 + h * FOXD) * 2; \
        _Pragma("unroll") for (int _i = 0; _i < 4; ++_i) { kr[_i] = *(const GAS u32x4*)(_b + (size_t)(16 * _i) * NIN * 2 + koff); vr[_i] = *(const GAS u32x4*)(_b + (size_t)(16 * _i) * NIN * 2 + 4096 + koff); } \
        if (t4 < 64) ckr = Cb[(j) * 64 + t4]; } while (0)
#define F4_STORE() do { _Pragma("unroll") for (int _i = 0; _i < 4; ++_i) { *(LAS u32x4*)(lds + F4_K + kl + 16 * _i * FX_KP) = kr[_i]; *(LAS u32x4*)(lds + F4_V + vl + 16 * _i * F4_VP) = vr[_i]; } \
        if (t4 < 64) *(LAS float*)(lds + F4_C + t4 * 4) = ckr; } while (0)
        F4_LOAD(0); F4_STORE();
        F4_BAR();
        for (int j = 0; j < ntiles; ++j) {
            if (j + 1 < ntiles) F4_LOAD(j + 1);
            if (64 * j <= qbase + 31) fox4_tile(lds + F4_K + kbase, lds + F4_V + vbase, lds + F4_C + hh * 16, QLw, j, qbase, q_abs, hh, cq2, o, mrun, lrun);
            F4_BAR();
            if (j + 1 < ntiles) F4_STORE();
            F4_BAR();
        }
#undef F4_LOAD
#undef F4_STORE
        const float ltot = lrun + __shfl_xor(lrun, 32); const float inv = 1.0f / ltot;
        bf16* orow = MIX + rowq * D + h * FOXD + 4 * hh;
#pragma unroll
        for (int d = 0; d < 4; ++d)
#pragma unroll
            for (int gI = 0; gI < 4; ++gI) { u32x2 w; w.x = pk2(o[d][4 * gI] * inv, o[d][4 * gI + 1] * inv); w.y = pk2(o[d][4 * gI + 2] * inv, o[d][4 * gI + 3] * inv);
                *(GAS u32x2*)(orow + 32 * d + 8 * gI) = w; }
    }
#undef F4_BAR
}

#ifndef MK_ONE_LAUNCH
#define MK_ONE_LAUNCH 1
#endif

constexpr int N_PHASES = 19;
#ifndef PROBE_REPS
#define PROBE_REPS {1,1,1,1,1, 1,1,1,1,1, 1,1,1,1,1, 1,1,1,1}
#endif
constexpr int REPS_[N_PHASES] = PROBE_REPS;
__global__ void __launch_bounds__(NTHR, 2) fwd(Args args_) {
    CArgs* argp_ = (CArgs*)__builtin_amdgcn_kernarg_segment_ptr(); asm volatile("" : "+s"(argp_)); CArgs& args = *argp_; (void)args_;
    extern __shared__ __attribute__((aligned(16))) unsigned char smem[];
    LAS unsigned char* lds = (LAS unsigned char*)smem;
    const int wave = __builtin_amdgcn_readfirstlane((int)threadIdx.x >> 6);
#define lane lane_id()
#define tid (wave * 64 + lane_id())
    const int G = gridDim.x, cid = blockIdx.x;
    volatile LAS unsigned* MISC = (volatile LAS unsigned*)(lds + MISC_OFF);
    for (int u = threadIdx.x; u < (LDS_BYTES - MISC_OFF) / 4; u += NTHR) MISC[u] = 0u;
    __syncthreads();
    const int lo = args.ph_lo, hi = args.ph_hi;
    unsigned* barw = (unsigned*)(args.ws + WS_CTL) + CW_BAR;
    XcdBarrier bar; bar.bar = barw; bar.x = 0; bar.st = MISC; bar.wave = wave;
    if (hi - lo > 1) bar = xcd_barrier_post(barw, MISC, wave);
#define IN(k) (lo <= (k) && (k) < hi)
#define SEAM(k) do { if (IN(k) && IN((k) + 1)) xcd_barrier(bar); } while (0)
    unsigned char* ws = args.ws;
    bf16* H = (bf16*)(ws + WS_H); bf16* U = (bf16*)(ws + WS_BIG); bf16* PROJ = (bf16*)(ws + WS_BIG); bf16* ACT2 = (bf16*)(ws + WS_ACT2);
    bf16* X = (bf16*)(ws + WS_X);
    bf16* Yb = (bf16*)(ws + WS_Y + 64 * MiB);
    const pg8::BatchOff Z0{0, 0, 1};

    if (IN(0)) { _Pragma("unroll") for (int rep_ = 0; rep_ < REPS_[0]; ++rep_) { if (rep_) xcd_barrier(bar); p0_prologue(args, lds, wave, lane); } SEAM(0); }
    if (IN(1)) { _Pragma("unroll") for (int rep_ = 0; rep_ < REPS_[1]; ++rep_) { if (rep_) xcd_barrier(bar);
        pg8::Gemm g{H, (const bf16*)(ws + WS_F1GU), D, D, D, Z0, Z0}; pg8::StaticOrder S; S.init(M, NGU, 1, G, cid);
        pg8::EpiSwiGLU E{U, FF, 1.0f};
        if (G == 256) {
            const int nall_full = S.nall; S.nall = 10 * 256;
            pg8::gemm_phase<pg8::EpiSwiGLU>(lds, g, S, E, wave);
            if (wave == 0 && lane == 0) MISC[24] = atomicAdd((unsigned*)(ws + WS_P1CTR), 1u);
            __syncthreads();
            const unsigned k11 = MISC[24];
            if (k11 < 192u) { pg8::StaticOrder S2 = S; S2.nall = nall_full; S2.G = nall_full; S2.c = 10 * 256 + (int)k11; pg8::gemm_phase<pg8::EpiSwiGLU>(lds, g, S2, E, wave); }
            else tail_cvt(args, lds, wave, lane, CVT_EARLY, CVT_TAIL, (int)k11 - 192, 64);
        } else pg8::gemm_phase<pg8::EpiSwiGLU>(lds, g, S, E, wave);
        } SEAM(1); }
    if (IN(2)) { _Pragma("unroll") for (int rep_ = 0; rep_ < REPS_[2]; ++rep_) { if (rep_) xcd_barrier(bar);
        pg8::Gemm g{U, (const bf16*)(ws + WS_F1D), FF, FF, FF, Z0, Z0}; pg8::StaticOrder S; S.init(M, D, 1, G, cid);
        pg8::EpiBf16 E{Yb, D, Z0, -1, nullptr}; pg8::gemm_phase<pg8::EpiBf16>(lds, g, S, E, wave); } SEAM(2); }
    if (IN(3)) { _Pragma("unroll") for (int rep_ = 0; rep_ < REPS_[3]; ++rep_) { if (rep_) xcd_barrier(bar); seam_phase<false, true, false>(args.in[I_X], Yb, X, H, args.in[I_F1POST], args.in[I_MIXPRE], 0.5f, wave, lane, (float*)(ws + WS_RSTD)); } SEAM(3); }
    if (IN(4)) { _Pragma("unroll") for (int rep_ = 0; rep_ < REPS_[4]; ++rep_) { if (rep_) xcd_barrier(bar);
        { pg8::Gemm g{X, (const bf16*)(ws + WS_W_IN), D, D, D, Z0, Z0}; pg8::StaticOrder S; S.init(M, NIN, 1, G, cid);
          pg8::EpiBf16R E{PROJ, NIN, 49, (float*)(ws + WS_FL), (const float*)(ws + WS_RSTD)}; pg8::gemm_phase<pg8::EpiBf16R>(lds, g, S, E, wave); }
        { pg8::Gemm g{(const bf16*)(ws + WS_MEMN), (const bf16*)(ws + WS_WK), D, D, D, Z0, Z0}; pg8::StaticOrder S; S.init(MM, D, 1, G, (cid + G - 64 % G) % G);
          pg8::EpiBf16 E{(bf16*)(ws + WS_KMEM), D, Z0, -1, nullptr}; pg8::gemm_phase<pg8::EpiBf16>(lds, g, S, E, wave); }
        { pg8::Gemm g{(const bf16*)(ws + WS_WV), (const bf16*)(ws + WS_MEMN), D, D, D, Z0, Z0}; pg8::StaticOrder S; S.init(D, MM, 1, G, (cid + G - 128 % G) % G);
          pg8::EpiBf16 E{(bf16*)(ws + WS_VT), MM, Z0, -1, nullptr}; pg8::gemm_phase<pg8::EpiBf16>(lds, g, S, E, wave); }
        if (G == 256 && cid >= 192) tail_cvt(args, lds, wave, lane, CVT_EARLY + CVT_TAIL, CVT_TAIL, cid - 192, 64);
        } SEAM(4); }
    if (IN(5)) { _Pragma("unroll") for (int rep_ = 0; rep_ < REPS_[5]; ++rep_) { if (rep_) xcd_barrier(bar); fox_cumsum_phase(args, lds, wave, lane); lora_act_phase(args, wave, lane); } SEAM(5); }
    if (IN(6)) { _Pragma("unroll") for (int rep_ = 0; rep_ < REPS_[6]; ++rep_) { if (rep_) xcd_barrier(bar);
        { pg8::Gemm g{(const bf16*)(ws + WS_ALORA), (const bf16*)(ws + WS_LORAW), ALD, LORA_K, 128, Z0, Z0}; pg8::StaticOrder S; S.init(M, RW, 1, G, cid);
          pg8::EpiLora<0> E{args.in[I_W0], (float*)(ws + WS_WDEC), nullptr}; pg8::gemm_phase<pg8::EpiLora<0>>(lds, g, S, E, wave); }
        { pg8::Gemm g{(const bf16*)(ws + WS_ALORA) + LORA_K, (const bf16*)(ws + WS_LORAW) + (size_t)RW * LORA_K, ALD, LORA_K, 128, Z0, Z0}; pg8::StaticOrder S; S.init(M, RW, 1, G, cid);
          pg8::EpiLora<1> E{args.in[I_A0], (float*)(ws + WS_AA), nullptr}; pg8::gemm_phase<pg8::EpiLora<1>>(lds, g, S, E, wave); }
        { pg8::Gemm g{(const bf16*)(ws + WS_ALORA) + 2 * LORA_K, (const bf16*)(ws + WS_LORAW) + (size_t)2 * RW * LORA_K, ALD, LORA_K, LORA_K, Z0, Z0}; pg8::StaticOrder S; S.init(M, RW, 1, G, cid);
          pg8::EpiLora<2> E{nullptr, nullptr, (bf16*)(ws + WS_G)}; pg8::gemm_phase<pg8::EpiLora<2>>(lds, g, S, E, wave); }
        } SEAM(6); }
    if (IN(7)) { _Pragma("unroll") for (int rep_ = 0; rep_ < REPS_[7]; ++rep_) { if (rep_) xcd_barrier(bar); for (int u = cid; u < 256; u += G) scan_unit(args, u, u == cid, lds, MISC + 4, tid, wave, lane); } SEAM(7); }
    if (IN(8)) { _Pragma("unroll") for (int rep_ = 0; rep_ < REPS_[8]; ++rep_) { if (rep_) xcd_barrier(bar); rwkv_post_phase(args, wave, lane); } SEAM(8); }
    if (IN(9)) { _Pragma("unroll") for (int rep_ = 0; rep_ < REPS_[9]; ++rep_) { if (rep_) xcd_barrier(bar);
        pg8::Gemm g{ACT2, (const bf16*)(ws + WS_W_OUT), D, D, D, Z0, Z0}; pg8::StaticOrder S; S.init(M, D, 1, G, cid);
        pg8::EpiBf16 E{Yb, D, Z0, -1, nullptr}; pg8::gemm_phase<pg8::EpiBf16>(lds, g, S, E, wave); } SEAM(9); }
    if (IN(10)) { _Pragma("unroll") for (int rep_ = 0; rep_ < REPS_[10]; ++rep_) { if (rep_) xcd_barrier(bar); seam_phase<false, false, false>(X, Yb, X, H, args.in[I_MIXPOST], args.in[I_XPRE], 1.0f, wave, lane, (float*)(ws + WS_RSTD)); } SEAM(10); }
    if (IN(11)) { _Pragma("unroll") for (int rep_ = 0; rep_ < REPS_[11]; ++rep_) { if (rep_) xcd_barrier(bar);
        pg8::Gemm g{X, (const bf16*)(ws + WS_WQ), D, D, D, Z0, Z0}; pg8::StaticOrder S; S.init(M, D, 1, G, cid);
        pg8::EpiBf16R E{ACT2, D, -1, nullptr, (const float*)(ws + WS_RSTD)}; pg8::gemm_phase<pg8::EpiBf16R>(lds, g, S, E, wave); } SEAM(11); }
    if (IN(12)) { _Pragma("unroll") for (int rep_ = 0; rep_ < REPS_[12]; ++rep_) { if (rep_) xcd_barrier(bar);
        pg8::Gemm g{ACT2, (const bf16*)(ws + WS_KMEM), D, D, 1024, pg8::BatchOff{(long)SEQ * D, 1024, 4}, pg8::BatchOff{(long)NMEM * D, 1024, 4}}; pg8::StaticOrder S; S.init(SEQ, NMEM, 16, G, cid);
        pg8::EpiSoftmax E{(bf16*)(ws + WS_BIG), 0.03125f * LOG2E}; pg8::gemm_phase<pg8::EpiSoftmax, false>(lds, g, S, E, wave); } SEAM(12); }
    if (IN(13)) { _Pragma("unroll") for (int rep_ = 0; rep_ < REPS_[13]; ++rep_) { if (rep_) xcd_barrier(bar);
        pg8::Gemm g{(const bf16*)(ws + WS_BIG), (const bf16*)(ws + WS_VT), NMEM, MM, NMEM, pg8::BatchOff{(long)SEQ * NMEM, 0, 1}, pg8::BatchOff{NMEM, (long)1024 * MM, 4}}; pg8::StaticOrder S; S.init(SEQ, 1024, 16, G, cid);
        pg8::EpiBf16 E{ACT2, D, pg8::BatchOff{(long)SEQ * D, 1024, 4}, -1, nullptr}; pg8::gemm_phase<pg8::EpiBf16>(lds, g, S, E, wave); } SEAM(13); }
    if (IN(14)) { _Pragma("unroll") for (int rep_ = 0; rep_ < REPS_[14]; ++rep_) { if (rep_) xcd_barrier(bar);
        pg8::Gemm g{ACT2, (const bf16*)(ws + WS_WO), D, D, D, Z0, Z0}; pg8::StaticOrder S; S.init(M, D, 1, G, cid);
        pg8::EpiBf16 E{Yb, D, Z0, -1, nullptr}; pg8::gemm_phase<pg8::EpiBf16>(lds, g, S, E, wave); } SEAM(14); }
    if (IN(15)) { _Pragma("unroll") for (int rep_ = 0; rep_ < REPS_[15]; ++rep_) { if (rep_) xcd_barrier(bar); seam_phase<true, false, false>(X, Yb, X, H, args.in[I_XPOST], args.in[I_F2PRE], 1.0f, wave, lane); } SEAM(15); }
    if (IN(16)) { _Pragma("unroll") for (int rep_ = 0; rep_ < REPS_[16]; ++rep_) { if (rep_) xcd_barrier(bar);
        pg8::Gemm g{H, (const bf16*)(ws + WS_F2GU), D / 2, D / 2, D / 2, Z0, Z0}; pg8::StaticOrder S; S.init(M, NGU, 1, G, cid);
        pg8::EpiSwiGLU8 E{(unsigned char*)U, FF, 1.0f / 512.0f};
        if (G == 256) {
            const int nall_full = S.nall; S.nall = 10 * 256;
            pg8::gemm_phase<pg8::EpiSwiGLU8, true, true, true>(lds, g, S, E, wave);
            if (wave == 0 && lane == 0) MISC[25] = atomicAdd((unsigned*)(ws + WS_P1CTR) + 16, 1u);
            __syncthreads();
            const unsigned k11 = MISC[25];
            if (k11 < 192u) { pg8::StaticOrder S2 = S; S2.nall = nall_full; S2.G = nall_full; S2.c = 10 * 256 + (int)k11; pg8::gemm_phase<pg8::EpiSwiGLU8, true, true, true>(lds, g, S2, E, wave); }
        } else pg8::gemm_phase<pg8::EpiSwiGLU8, true, true, true>(lds, g, S, E, wave);
        } SEAM(16); }
    if (IN(17)) { _Pragma("unroll") for (int rep_ = 0; rep_ < REPS_[17]; ++rep_) { if (rep_) xcd_barrier(bar);
        pg8::Gemm g{U, (const bf16*)(ws + WS_F2D), FF / 2, FF / 2, FF / 2, Z0, Z0}; pg8::StaticOrder S; S.init(M, D, 1, G, cid);
        pg8::EpiBf16S E{Yb, D, 1.0f / 1024.0f}; pg8::gemm_phase<pg8::EpiBf16S, true, true, true>(lds, g, S, E, wave); } SEAM(17); }
    if (IN(18)) { _Pragma("unroll") for (int rep_ = 0; rep_ < REPS_[18]; ++rep_) { if (rep_) xcd_barrier(bar); seam_phase<false, false, true>(X, Yb, args.out, nullptr, args.in[I_F2POST], nullptr, 0.5f, wave, lane); } }
#undef IN
#undef SEAM
#undef lane
#undef tid
}

extern "C" void kernel_launch(void* const* d_in, const int* in_sizes, int n_in, void* d_out, int out_size, void* d_ws, size_t ws_size, hipStream_t stream) {
    static int grid = 0;
    if (grid == 0) {
        if (n_in != 35 || in_sizes[0] != M * D || out_size != M * D || ws_size < WS_END) { fprintf(stderr, "kernel_launch: unexpected shapes (n_in %d, in0 %d, out %d, ws %zu < %zu)\n", n_in, n_in > 0 ? in_sizes[0] : -1, out_size, ws_size, (size_t)WS_END); grid = -1; return; }
        int dev = 0, cus = 0;
        if (hipGetDevice(&dev) != hipSuccess || hipDeviceGetAttribute(&cus, hipDeviceAttributeMultiprocessorCount, dev) != hipSuccess) { grid = -1; return; }
        if (hipFuncSetAttribute((const void*)fwd, hipFuncAttributeMaxDynamicSharedMemorySize, LDS_BYTES) != hipSuccess) { fprintf(stderr, "kernel_launch: hipFuncSetAttribute failed\n"); grid = -1; return; }
        int per_cu = 0;
        if (hipOccupancyMaxActiveBlocksPerMultiprocessor(&per_cu, (const void*)fwd, NTHR, LDS_BYTES) != hipSuccess || per_cu < 1) { fprintf(stderr, "kernel_launch: occupancy query says %d\n", per_cu); (void)hipGetLastError(); }
        grid = cus;
    }
    if (grid < 0) return;
    (void)hipMemsetAsync((char*)d_ws + WS_CTL, 0, CTL_ZERO_BYTES, stream);
    Args a{};
    for (int i = 0; i < 35; ++i) a.in[i] = (const float*)d_in[i];
    a.out = (float*)d_out; a.ws = (unsigned char*)d_ws;
#if MK_ONE_LAUNCH
    a.ph_lo = 0; a.ph_hi = N_PHASES;
    hipLaunchKernelGGL(fwd, dim3(grid), dim3(NTHR), LDS_BYTES, stream, a);
#else
    for (int p = MK_PH_BEG; p < MK_PH_END; ++p) { a.ph_lo = p; a.ph_hi = p + 1; hipLaunchKernelGGL(fwd, dim3(grid), dim3(NTHR), LDS_BYTES, stream, a); }
#endif
}
```
